# Optimizing an MI355X kernel written in HIP

```python
import math
import jax, jax.numpy as jnp
from jax import lax
import numpy as np

D_MODEL = 2048
BATCH = 2
SEQ = 4096
DEPTH = 1

N_META = 16
EPS = 1e-6
MLA_HEADS = 16
Q_LORA = 512
KV_LORA = 512
QK_NOPE = 128
QK_ROPE = 64
V_HEAD = 128
ROPE_THETA = 10000.0
Q_BLOCK = 128
SSM_WIDTH = 1024
SSM_GROUP = 16
SSM_GROUPS = SSM_WIDTH // SSM_GROUP
SSM_STATE = 64
DT_MIN = 1e-3
DT_MAX = 1e-1
N_BRANCH = 2
D_FF = -(-8 * D_MODEL // (3 * 256)) * 256
OFF_Q = Q_LORA
OFF_KV = OFF_Q + KV_LORA
OFF_KR = OFF_KV + QK_ROPE
OFF_U = OFF_KR + SSM_WIDTH
IN_WIDTH = OFF_U + N_BRANCH * D_MODEL

kernel_name = "hybrid_mla_s5_gated_block"


def rms_norm(x, g):
    xf = x.astype(jnp.float32)
    y = xf * lax.rsqrt(jnp.mean(xf * xf, axis=-1, keepdims=True) + EPS)
    return y.astype(x.dtype) * g.astype(x.dtype)


def rope_tables(length):
    half = QK_ROPE // 2
    freqs = ROPE_THETA ** (-jnp.arange(half, dtype=jnp.float32) / half)
    ang = jnp.arange(length, dtype=jnp.float32)[:, None] * freqs[None, :]
    return jnp.cos(ang), jnp.sin(ang)


def apply_rope(x, cos, sin):
    half = QK_ROPE // 2
    x1, x2 = x[..., :half], x[..., half:]
    c, s = cos.astype(x.dtype), sin.astype(x.dtype)
    return jnp.concatenate([x1 * c - x2 * s, x2 * c + x1 * s], axis=-1)


def mla_attention(q_nope, q_rope, k_nope, k_rope, v):
    length = q_nope.shape[1]
    scale = (QK_NOPE + QK_ROPE) ** -0.5
    outs = []
    for start in range(0, length, Q_BLOCK):
        end = min(start + Q_BLOCK, length)
        s = (jnp.einsum('bqhd,bkhd->bhqk', q_nope[:, start:end], k_nope[:, :end])
             + jnp.einsum('bqhr,bkr->bhqk', q_rope[:, start:end], k_rope[:, :end]))
        s = s.astype(jnp.float32) * scale
        q_pos = jnp.arange(start, end)[:, None]
        k_pos = jnp.arange(end)[None, :]
        s = jnp.where(k_pos <= q_pos, s, -jnp.inf)
        p = jax.nn.softmax(s, axis=-1).astype(v.dtype)
        outs.append(jnp.einsum('bhqk,bkhd->bqhd', p, v[:, :end]))
    return jnp.concatenate(outs, axis=1)


def s5_scan(u, lam_re, lam_im, log_step, b_re, b_im, c_re, c_im, d):
    f32 = jnp.float32
    step = jnp.exp(log_step.astype(f32))[:, None]
    lr, li = lam_re.astype(f32), lam_im.astype(f32)
    mag = jnp.exp(lr * step)
    ab_re, ab_im = mag * jnp.cos(li * step), mag * jnp.sin(li * step)
    den = lr * lr + li * li
    nr, ni = ab_re - 1.0, ab_im
    coef_re = (nr * lr + ni * li) / den
    coef_im = (ni * lr - nr * li) / den
    br, bi = b_re.astype(f32), b_im.astype(f32)
    bb_re = coef_re[..., None] * br - coef_im[..., None] * bi
    bb_im = coef_re[..., None] * bi + coef_im[..., None] * br
    uf = u.astype(f32)
    bu_re = jnp.einsum('blgp,gnp->blgn', uf, bb_re)
    bu_im = jnp.einsum('blgp,gnp->blgn', uf, bb_im)
    a_re = jnp.broadcast_to(ab_re, bu_re.shape)
    a_im = jnp.broadcast_to(ab_im, bu_im.shape)

    def combine(e1, e2):
        a1r, a1i, b1r, b1i = e1
        a2r, a2i, b2r, b2i = e2
        return (a2r * a1r - a2i * a1i,
                a2r * a1i + a2i * a1r,
                a2r * b1r - a2i * b1i + b2r,
                a2r * b1i + a2i * b1r + b2i)

    _, _, x_re, x_im = lax.associative_scan(combine, (a_re, a_im, bu_re, bu_im), axis=1)
    y = (jnp.einsum('blgn,gpn->blgp', x_re, c_re.astype(f32))
         - jnp.einsum('blgn,gpn->blgp', x_im, c_im.astype(f32))
         + d.astype(f32) * uf)
    return y


def setup_inputs(seed: int = 0) -> dict:
    key = jax.random.key(seed)
    ks = jax.random.split(key, 32)
    f32 = jnp.float32
    nrm = lambda k, shape, scale: jax.random.normal(k, shape, f32) * scale
    gain = lambda k, shape: 1.0 + 0.02 * jax.random.normal(k, shape, f32)
    G, N, P = SSM_GROUPS, SSM_STATE, SSM_GROUP
    lam_re = -0.5 * jnp.exp(0.05 * jax.random.normal(ks[9], (DEPTH, G, N), f32))
    lam_im = jnp.broadcast_to(math.pi * jnp.arange(N, dtype=f32), (DEPTH, G, N))
    log_step = jax.random.uniform(ks[10], (DEPTH, G), f32, math.log(DT_MIN), math.log(DT_MAX))
    return {
        "x": nrm(ks[0], (BATCH, SEQ, D_MODEL), 1.0),
        "meta_tokens": nrm(ks[1], (N_META, D_MODEL), 1.0),
        "norm_mix": gain(ks[2], (DEPTH, D_MODEL)),
        "w_in": nrm(ks[3], (DEPTH, D_MODEL, IN_WIDTH), D_MODEL ** -0.5),
        "norm_q": gain(ks[4], (DEPTH, Q_LORA)),
        "w_q_up": nrm(ks[5], (DEPTH, Q_LORA, MLA_HEADS * (QK_NOPE + QK_ROPE)), Q_LORA ** -0.5),
        "norm_kv": gain(ks[6], (DEPTH, KV_LORA)),
        "w_kv_up": nrm(ks[7], (DEPTH, KV_LORA, MLA_HEADS * (QK_NOPE + V_HEAD)), KV_LORA ** -0.5),
        "w_attn_proj": nrm(ks[8], (DEPTH, MLA_HEADS * V_HEAD, D_MODEL), (MLA_HEADS * V_HEAD) ** -0.5),
        "ssm_lambda_re": lam_re,
        "ssm_lambda_im": lam_im,
        "ssm_log_step": log_step,
        "ssm_b_re": nrm(ks[11], (DEPTH, G, N, P), (2 * P) ** -0.5),
        "ssm_b_im": nrm(ks[12], (DEPTH, G, N, P), (2 * P) ** -0.5),
        "ssm_c_re": nrm(ks[13], (DEPTH, G, P, N), N ** -0.5),
        "ssm_c_im": nrm(ks[14], (DEPTH, G, P, N), N ** -0.5),
        "ssm_d": nrm(ks[15], (DEPTH, G, P), 1.0),
        "w_glu_val": nrm(ks[16], (DEPTH, SSM_WIDTH, D_MODEL), SSM_WIDTH ** -0.5),
        "w_glu_gate": nrm(ks[17], (DEPTH, SSM_WIDTH, D_MODEL), SSM_WIDTH ** -0.5),
        "w_out": nrm(ks[18], (DEPTH, D_MODEL, D_MODEL), D_MODEL ** -0.5),
        "norm_ffn": gain(ks[19], (DEPTH, D_MODEL)),
        "w_ffn_gate": nrm(ks[20], (DEPTH, D_MODEL, D_FF), D_MODEL ** -0.5),
        "w_ffn_up": nrm(ks[21], (DEPTH, D_MODEL, D_FF), D_MODEL ** -0.5),
        "w_ffn_down": nrm(ks[22], (DEPTH, D_FF, D_MODEL), D_FF ** -0.5),
        "norm_final": gain(ks[23], (D_MODEL,)),
    }


def reference(x, meta_tokens, norm_mix, w_in, norm_q, w_q_up, norm_kv, w_kv_up, w_attn_proj,
              ssm_lambda_re, ssm_lambda_im, ssm_log_step, ssm_b_re, ssm_b_im, ssm_c_re, ssm_c_im,
              ssm_d, w_glu_val, w_glu_gate, w_out, norm_ffn, w_ffn_gate, w_ffn_up, w_ffn_down,
              norm_final):
    bsz = x.shape[0]
    meta = jnp.broadcast_to(meta_tokens[None].astype(x.dtype), (bsz, N_META, D_MODEL))
    h = jnp.concatenate([meta, x], axis=1)
    length = h.shape[1]
    cos, sin = rope_tables(length)
    for l in range(DEPTH):
        n = rms_norm(h, norm_mix[l])
        z = n @ w_in[l]
        q_lat, kv_lat, k_r, u, gates = jnp.split(z, [OFF_Q, OFF_KV, OFF_KR, OFF_U], axis=-1)
        q = (rms_norm(q_lat, norm_q[l]) @ w_q_up[l]).reshape(bsz, length, MLA_HEADS, QK_NOPE + QK_ROPE)
        kv = (rms_norm(kv_lat, norm_kv[l]) @ w_kv_up[l]).reshape(bsz, length, MLA_HEADS, QK_NOPE + V_HEAD)
        q_nope = q[..., :QK_NOPE]
        q_rope = apply_rope(q[..., QK_NOPE:], cos[:, None, :], sin[:, None, :])
        k_nope, v = kv[..., :QK_NOPE], kv[..., QK_NOPE:]
        k_rope = apply_rope(k_r, cos, sin)
        attn = mla_attention(q_nope, q_rope, k_nope, k_rope, v).reshape(bsz, length, MLA_HEADS * V_HEAD)
        attn_out = attn @ w_attn_proj[l]
        y = s5_scan(u.reshape(bsz, length, SSM_GROUPS, SSM_GROUP),
                    ssm_lambda_re[l], ssm_lambda_im[l], ssm_log_step[l],
                    ssm_b_re[l], ssm_b_im[l], ssm_c_re[l], ssm_c_im[l], ssm_d[l])
        y = jax.nn.gelu(y.reshape(bsz, length, SSM_WIDTH).astype(h.dtype))
        ssm_out = (y @ w_glu_val[l]) * jax.nn.sigmoid(y @ w_glu_gate[l])
        g = gates.reshape(bsz, length, N_BRANCH, D_MODEL)
        mixed = jax.nn.sigmoid(g[:, :, 0]) * attn_out + jax.nn.sigmoid(g[:, :, 1]) * ssm_out
        h = h + mixed @ w_out[l]
        m = rms_norm(h, norm_ffn[l])
        h = h + (jax.nn.silu(m @ w_ffn_gate[l]) * (m @ w_ffn_up[l])) @ w_ffn_down[l]
    out = rms_norm(h, norm_final)
    return out[:, N_META:]
```

```cpp
#include <hip/hip_runtime.h>
#include <cstdio>
#include <cstdint>

#define LAS __attribute__((address_space(3)))
#define GAS __attribute__((address_space(1)))
typedef unsigned short bf16;
typedef short bf16x8 __attribute__((ext_vector_type(8)));
typedef short s16x4 __attribute__((ext_vector_type(4)));
typedef float f32x2 __attribute__((ext_vector_type(2)));
typedef float f32x4 __attribute__((ext_vector_type(4)));
typedef float f32x16 __attribute__((ext_vector_type(16)));
typedef unsigned u32x2 __attribute__((ext_vector_type(2)));
typedef unsigned u32x4 __attribute__((ext_vector_type(4)));

#ifndef MK_SPLIT
#define MK_SPLIT 0
#endif

constexpr int DM = 2048, SEQ = 4096, NBATCH = 2, NMETA = 16, LTOT = SEQ + NMETA, LPAD = 4160;
constexpr int MTOK = NBATCH * SEQ;
constexpr int MROWS = MTOK + 256;
constexpr int NH = 16, DQK = 192, DNOPE = 128, DROPE = 64, DV = 128, QLORA = 512, KVLORA = 512;
constexpr int SSMW = 1024, NG = 64, NS = 64, TC = 16, NCH = SEQ / TC  , KY = 384, KS = 256;
constexpr int DFF = 5632, INW = 6208, NWIN = 6400;
constexpr float EPS = 1e-6f;
constexpr float QSCALE = 0.07216878364870322f * 1.4426950408889634f;
constexpr int NWAVES = 8;
constexpr int N_PHASES = 11;

constexpr size_t MiB = 1u << 20;
constexpr size_t WS_CTL = 0, CTL_ZERO_BYTES = 1 * MiB;
constexpr int CW_TMO = 0, CW_BAR = 4096;
constexpr size_t OFF_SSQ_Q = 64 * 1024, OFF_SSQ_KV = 128 * 1024, OFF_SSQ_H1 = 192 * 1024, OFF_SSQ_H2 = 256 * 1024;
constexpr size_t WS_RS1 = 1 * MiB;
constexpr size_t WS_CS = 1 * MiB + 64 * 1024;
constexpr size_t WS_APOW = 2 * MiB + 256 * 1024;
constexpr size_t WS_BBAR = 3 * MiB;
constexpr size_t WS_X0 = 3 * MiB + 512 * 1024;
constexpr size_t WS_UMETA = 3 * MiB + 576 * 1024;
constexpr size_t WS_WIN = 4 * MiB;
constexpr size_t WS_SLOC = 4 * MiB;
constexpr size_t WS_P = 4 * MiB;
constexpr size_t WS_H1B = 4 * MiB;
constexpr size_t WS_WQ = 29 * MiB;
constexpr size_t WS_WKV = 32 * MiB;
constexpr size_t WS_BTS = 36 * MiB;
constexpr size_t WS_BTY = 41 * MiB;
constexpr size_t WS_WGLU = 53 * MiB;
constexpr size_t WS_WAP = 61 * MiB;
constexpr size_t WS_F = 36 * MiB;
constexpr size_t WS_XB = 69 * MiB;
constexpr size_t WS_O = 69 * MiB;
constexpr size_t WS_UA = 102 * MiB;
constexpr size_t WS_MIXED = 102 * MiB;
constexpr size_t WS_QLAT = 126 * MiB;
constexpr size_t WS_Y = 126 * MiB;
constexpr size_t WS_KVLAT = 134 * MiB;
constexpr size_t WS_KR = 143 * MiB;
constexpr size_t WS_Q = 145 * MiB;
constexpr size_t WS_KN = 193 * MiB;
constexpr size_t WS_V = 226 * MiB;
constexpr size_t WS_WOUT = 170 * MiB;
constexpr size_t WS_WFFN = 178 * MiB;
constexpr size_t WS_WDOWN = 222 * MiB;
constexpr size_t WS_END = 259 * MiB;
static_assert(WS_WDOWN + (size_t)2048 * 5632 * 2 <= 244 * MiB && WS_V + (size_t)2 * 16 * 4160 * 128 * 2 <= WS_END, "ws map");
static_assert(WS_F + (size_t)8192 * 5632 * 2 <= WS_QLAT && WS_UA + (size_t)NG * 512 * KY * 2 <= WS_QLAT, "ws map 2");

constexpr int RING_BYTES = 131072;
constexpr int LDSCTL_OFF = RING_BYTES, MISC_OFF = LDSCTL_OFF + 320;
constexpr int LDS_BYTES = 147456;

#define RLX_AGENT __ATOMIC_RELAXED, __HIP_MEMORY_SCOPE_AGENT
#define LDS_WAIT() asm volatile("s_waitcnt lgkmcnt(0)" ::: "memory")
#define VM_WAIT() asm volatile("s_waitcnt vmcnt(0)" ::: "memory")
#define SBAR() __builtin_amdgcn_sched_barrier(0)
__device__ __forceinline__ unsigned cvt_pk_bf16(float lo, float hi) { unsigned r; asm volatile("v_cvt_pk_bf16_f32 %0, %1, %2" : "=v"(r) : "v"(lo), "v"(hi)); return r; }
__device__ __forceinline__ float bf_lo(unsigned w) { return __uint_as_float(w << 16); }
__device__ __forceinline__ float bf_hi(unsigned w) { return __uint_as_float(w & 0xffff0000u); }
__device__ __forceinline__ float fast_sigmoid(float x) { return __builtin_amdgcn_rcpf(1.0f + __builtin_amdgcn_exp2f(-1.4426950408889634f * x)); }
__device__ __forceinline__ float gelu_tanh(float x) { const float z = 0.7978845608028654f * (x + 0.044715f * x * x * x); return x * fast_sigmoid(2.0f * z); }
__device__ __forceinline__ u32x4 pack8(const f32x4 a, const f32x4 b) { u32x4 w; w.x = cvt_pk_bf16(a[0], a[1]); w.y = cvt_pk_bf16(a[2], a[3]); w.z = cvt_pk_bf16(b[0], b[1]); w.w = cvt_pk_bf16(b[2], b[3]); return w; }
__device__ __forceinline__ void unpack8(const u32x4 w, f32x4& a, f32x4& b) { a = (f32x4){bf_lo(w.x), bf_hi(w.x), bf_lo(w.y), bf_hi(w.y)}; b = (f32x4){bf_lo(w.z), bf_hi(w.z), bf_lo(w.w), bf_hi(w.w)}; }

struct Args { const float* in[25]; float* out; unsigned char* ws; int ph_lo, ph_hi; };
struct PtrsT {
    const Args& a;
    __device__ __forceinline__ explicit PtrsT(const Args& a_) : a(a_) {}
#define PIN(name, idx) __device__ __forceinline__ const float* name##_() const { return a.in[idx]; }
    PIN(x, 0) PIN(meta, 1) PIN(norm_mix, 2) PIN(w_in, 3) PIN(norm_q, 4) PIN(w_q_up, 5) PIN(norm_kv, 6) PIN(w_kv_up, 7) PIN(w_attn_proj, 8) PIN(lam_re, 9) PIN(lam_im, 10) PIN(log_step, 11)
    PIN(b_re, 12) PIN(b_im, 13) PIN(c_re, 14) PIN(c_im, 15) PIN(ssm_d, 16) PIN(w_glu_val, 17) PIN(w_glu_gate, 18) PIN(w_out, 19) PIN(norm_ffn, 20) PIN(w_ffn_gate, 21) PIN(w_ffn_up, 22)
    PIN(w_ffn_down, 23) PIN(norm_final, 24)
#undef PIN
#define PWS(type, name, off) __device__ __forceinline__ type* name##_() const { return (type*)(a.ws + (off)); }
    PWS(unsigned, ctl, WS_CTL) PWS(float, ssq_q, OFF_SSQ_Q) PWS(float, ssq_kv, OFF_SSQ_KV) PWS(float, ssq_h1, OFF_SSQ_H1) PWS(float, ssq_h2, OFF_SSQ_H2) PWS(float, rs1, WS_RS1) PWS(float, umeta, WS_UMETA)
    PWS(float, sloc, WS_SLOC) PWS(f32x2, cs, WS_CS) PWS(f32x2, apow, WS_APOW) PWS(f32x2, bbar, WS_BBAR) PWS(f32x2, x0, WS_X0)
    PWS(bf16, win, WS_WIN) PWS(bf16, wq, WS_WQ) PWS(bf16, wkv, WS_WKV) PWS(bf16, bts, WS_BTS) PWS(bf16, bty, WS_BTY) PWS(bf16, wglu, WS_WGLU) PWS(bf16, wap, WS_WAP) PWS(bf16, wout, WS_WOUT)
    PWS(bf16, wffn, WS_WFFN) PWS(bf16, wdown, WS_WDOWN) PWS(bf16, xb, WS_XB) PWS(bf16, qlat, WS_QLAT) PWS(bf16, kvlat, WS_KVLAT) PWS(bf16, ua, WS_UA) PWS(bf16, kr, WS_KR) PWS(bf16, q, WS_Q)
    PWS(bf16, kn, WS_KN) PWS(bf16, v, WS_V) PWS(bf16, o, WS_O) PWS(bf16, y, WS_Y) PWS(bf16, pbuf, WS_P) PWS(bf16, mixed, WS_MIXED) PWS(bf16, h1b, WS_H1B) PWS(bf16, f, WS_F)
#undef PWS
    __device__ __forceinline__ float* out_() const { return a.out; }
    __device__ __forceinline__ bf16* sg_() const { return (bf16*)a.out; }
};
typedef PtrsT Ptrs;

namespace pg8 {
constexpr int BM = 256, BK = 64, HALF = 128, HTB = HALF * BK * 2, STAGE_BYTES = 8 * HTB, NXCD = 8, WGM = 8;
__host__ __device__ __forceinline__ int lds_byte(int r, int c) { const int st = (r >> 4) * 2 + (c >> 5), rr = r & 15, cc = c & 31, ob = rr * 64 + cc * 2; return st * 1024 + (ob ^ (((ob >> 9) & 1) << 5)); }
__host__ __device__ __forceinline__ void stage_rc(int b, int& R, int& C) { const int st = b / 1024, sb = b % 1024, swz = sb ^ (((sb >> 9) & 1) << 5); R = (st >> 1) * 16 + swz / 64; C = (st & 1) * 32 + (swz % 64) / 2; }
__host__ __device__ __forceinline__ int perm32(int rho) { const int n = rho >> 4, i = rho & 15; return 8 * (i >> 2) + 4 * n + (i & 3); }

struct Unit { const char* A; const char* B; unsigned lda, ldb; int nt, pm, pn, kind, aux; };

__device__ __forceinline__ void tile_order(int L, int nM, int nN, int& pm, int& pn) {
    const int nwg = nM * nN; int wgid = L;
    { const int q = nwg / NXCD, r = nwg % NXCD, xcd = wgid % NXCD, off = wgid / NXCD; wgid = (xcd < r ? xcd * (q + 1) : r * (q + 1) + (xcd - r) * q) + off; }
    const int nig = WGM * nN, gid = wgid / nig, fm = gid * WGM, gsz = (nM - fm) < WGM ? (nM - fm) : WGM;
    pm = fm + ((wgid % nig) % gsz); pn = (wgid % nig) / gsz;
}

template <class Sched, class Epi>
__device__ __forceinline__ void gemm_run(LAS unsigned char* lds, const Sched& S, const Epi& E) {
    const int tid = threadIdx.x, wid = __builtin_amdgcn_readfirstlane(tid >> 6), lane = tid & 63, wr = wid >> 2, wc = wid & 3, fr = lane & 15, fq = lane >> 4;
    unsigned RA[2], RB[2], C2[2];
#pragma unroll
    for (int i = 0; i < 2; ++i) { int R, C; stage_rc(tid * 16 + i * 8192, R, C); RA[i] = (unsigned)R; RB[i] = (unsigned)((R & ~31) + perm32(R & 31)); C2[i] = (unsigned)(C * 2); }
    const unsigned ldsw = (unsigned)wid * 1024u;
    const int aoff = lds_byte(wr * 64 + fr, fq * 8), boff = lds_byte(wc * 32 + fr, fq * 8);
#define PG8_SA(b, h) (((b) * 2 + (h)) * HTB)
#define PG8_SB(b, h) ((4 + (b) * 2 + (h)) * HTB)
#define PG8_STAGE(bufoff, gbase, RR, ld) do { _Pragma("unroll") for (int _i = 0; _i < 2; ++_i) \
        __builtin_amdgcn_global_load_lds((const unsigned*)((const char*)(gbase) + (RR)[_i] * (ld) + C2[_i]), (LAS unsigned*)(lds + (bufoff) + ldsw + _i * 8192), 16, 0, 0); } while (0)
#define PG8_LDA(dst, b, h) do { _Pragma("unroll") for (int m = 0; m < 4; ++m) _Pragma("unroll") for (int k = 0; k < 2; ++k) dst[m][k] = *(const LAS bf16x8*)(lds + PG8_SA(b, h) + aoff + m * 2048 + k * 1024); } while (0)
#define PG8_LDB(dst, b, h) do { _Pragma("unroll") for (int n = 0; n < 2; ++n) _Pragma("unroll") for (int k = 0; k < 2; ++k) dst[n][k] = *(const LAS bf16x8*)(lds + PG8_SB(b, h) + boff + n * 2048 + k * 1024); } while (0)
#define PG8_MMA(ai, bj, At, Bt) do { __builtin_amdgcn_s_setprio(1); _Pragma("unroll") for (int m = 0; m < 4; ++m) _Pragma("unroll") for (int n = 0; n < 2; ++n) _Pragma("unroll") for (int k = 0; k < 2; ++k) \
        acc[ai][bj][m][n] = __builtin_amdgcn_mfma_f32_16x16x32_bf16(Bt[n][k], At[m][k], acc[ai][bj][m][n], 0, 0, 0); __builtin_amdgcn_s_setprio(0); } while (0)
#define PG8_WAIT_V(n) asm volatile("s_waitcnt vmcnt(" #n ")" ::: "memory")
#define PG8_WAIT_L(n) asm volatile("s_waitcnt lgkmcnt(" #n ")" ::: "memory")
#define PG8_BAR __builtin_amdgcn_s_barrier()
#define PG8_SCHED __builtin_amdgcn_sched_barrier(0)
    Unit cur, nxt; int ui = 0;
    if (!S.next(0, cur)) return;
    f32x4 acc[2][2][4][2];
#pragma unroll
    for (int a = 0; a < 2; ++a)
#pragma unroll
        for (int b = 0; b < 2; ++b)
#pragma unroll
            for (int m = 0; m < 4; ++m)
#pragma unroll
                for (int n = 0; n < 2; ++n) acc[a][b][m][n] = (f32x4){0.f, 0.f, 0.f, 0.f};
    bf16x8 At[4][2], B0[2][2], B1[2][2];
    const char* cA = cur.A; const char* cB = cur.B; unsigned lda = cur.lda, ldb = cur.ldb;
    constexpr unsigned kstep = BK * 2;
    PG8_STAGE(PG8_SB(0, 0), cB, RB, ldb); PG8_STAGE(PG8_SB(0, 1), cB + (size_t)HALF * ldb, RB, ldb); PG8_STAGE(PG8_SA(0, 0), cA, RA, lda); PG8_STAGE(PG8_SA(0, 1), cA + (size_t)HALF * lda, RA, lda);
    if (wr == 1) PG8_BAR;
    PG8_WAIT_V(2); PG8_BAR;
    PG8_STAGE(PG8_SB(1, 0), cB + kstep, RB, ldb); PG8_STAGE(PG8_SA(1, 0), cA + kstep, RA, lda); PG8_STAGE(PG8_SB(1, 1), cB + (size_t)HALF * ldb + kstep, RB, ldb);
    PG8_WAIT_V(6); PG8_BAR;
    for (;;) {
        const bool has_next = S.next(ui + 1, nxt);
        const char* nA = has_next ? nxt.A : cA; const char* nB = has_next ? nxt.B : cB; const unsigned nlda = has_next ? nxt.lda : lda, nldb = has_next ? nxt.ldb : ldb;
        const int nt = cur.nt;
        for (int t = 0; t < nt; t += 2) {
            const bool last = (t == nt - 2);
            const char* a1 = cA + (size_t)(t + 1) * kstep;
            const char* a2 = last ? nA : cA + (size_t)(t + 2) * kstep; const char* b2 = last ? nB : cB + (size_t)(t + 2) * kstep;
            const unsigned la2 = last ? nlda : lda, lb2 = last ? nldb : ldb;
            const char* a3 = a2 + kstep; const char* b3 = b2 + kstep;
            PG8_LDB(B0, 0, 0); PG8_LDB(B1, 0, 1); PG8_SCHED; PG8_LDA(At, 0, 0); PG8_STAGE(PG8_SA(1, 1), a1 + (size_t)HALF * lda, RA, lda);
            PG8_WAIT_V(8); PG8_WAIT_L(0); PG8_BAR; PG8_MMA(0, 0, At, B0); PG8_MMA(0, 1, At, B1); PG8_BAR; PG8_SCHED;
            PG8_LDA(At, 0, 1); PG8_STAGE(PG8_SB(0, 0), b2, RB, lb2); PG8_STAGE(PG8_SB(0, 1), b2 + (size_t)HALF * lb2, RB, lb2); PG8_STAGE(PG8_SA(0, 0), a2, RA, la2);
            PG8_WAIT_V(8); PG8_WAIT_L(0); PG8_BAR; PG8_MMA(1, 0, At, B0); PG8_MMA(1, 1, At, B1); PG8_BAR; PG8_SCHED;
            PG8_LDB(B0, 1, 0); PG8_LDB(B1, 1, 1); PG8_SCHED; PG8_LDA(At, 1, 0); PG8_STAGE(PG8_SA(0, 1), a2 + (size_t)HALF * la2, RA, la2);
            PG8_WAIT_V(8); PG8_WAIT_L(0); PG8_BAR; PG8_MMA(0, 0, At, B0); PG8_MMA(0, 1, At, B1); PG8_BAR; PG8_SCHED;
            PG8_LDA(At, 1, 1); PG8_STAGE(PG8_SB(1, 0), b3, RB, lb2); PG8_STAGE(PG8_SB(1, 1), b3 + (size_t)HALF * lb2, RB, lb2); PG8_STAGE(PG8_SA(1, 0), a3, RA, la2);
            PG8_WAIT_V(8); PG8_WAIT_L(0); PG8_BAR; PG8_MMA(1, 0, At, B0); PG8_MMA(1, 1, At, B1); PG8_BAR; PG8_SCHED;
        }
        if (wr == 0) PG8_BAR;
        E(acc, cur, wr, wc, fr, fq);
        if (!has_next) break;
#pragma unroll
        for (int a = 0; a < 2; ++a)
#pragma unroll
            for (int b = 0; b < 2; ++b)
#pragma unroll
                for (int m = 0; m < 4; ++m)
#pragma unroll
                    for (int n = 0; n < 2; ++n) acc[a][b][m][n] = (f32x4){0.f, 0.f, 0.f, 0.f};
        cur = nxt; cA = nA; cB = nB; lda = nlda; ldb = nldb; ++ui;
        if (wr == 1) PG8_BAR;
    }
    PG8_WAIT_V(0);
    PG8_BAR;
#undef PG8_SA
#undef PG8_SB
#undef PG8_STAGE
#undef PG8_LDA
#undef PG8_LDB
#undef PG8_MMA
#undef PG8_WAIT_V
#undef PG8_WAIT_L
#undef PG8_BAR
#undef PG8_SCHED
}
}
using pg8::Unit;

enum { K_QLAT = 0, K_KVLAT, K_U, K_GATES, K_KR, K_QN, K_QR, K_KV, K_SLOC, K_Y, K_GLU, K_AP, K_OUT, K_FFN, K_DOWN };

template <int PH> struct Epi {
    const Ptrs& P;
    __device__ __forceinline__ explicit Epi(const Ptrs& p) : P(p) {}
    __device__ __forceinline__ void operator()(f32x4 (&acc)[2][2][4][2], const Unit& u, int wr, int wc, int fr, int fq) const {
        const int kind = u.kind;
#pragma unroll
        for (int ai = 0; ai < 2; ++ai)
#pragma unroll
            for (int m = 0; m < 4; ++m) {
                const int rt = ai * 128 + wr * 64 + m * 16 + fr;
                const int row = u.pm * 256 + rt;
                const int c8 = wc * 32 + fq * 8;
                if constexpr (PH == 1) {
                    const float rs = P.rs1_()[row];
                    if (kind == K_QLAT || kind == K_KVLAT) {
                        bf16* dst = (kind == K_QLAT ? P.qlat_() : P.kvlat_()) + (size_t)row * 512 + (u.pn & 1) * 256 + c8;
                        float ss = 0.f;
#pragma unroll
                        for (int bj = 0; bj < 2; ++bj) { const f32x4 v0 = acc[ai][bj][m][0] * rs, v1 = acc[ai][bj][m][1] * rs;
                            ss += (v0[0] * v0[0] + v0[1] * v0[1]) + (v0[2] * v0[2] + v0[3] * v0[3]) + (v1[0] * v1[0] + v1[1] * v1[1]) + (v1[2] * v1[2] + v1[3] * v1[3]);
                            *(u32x4*)(dst + bj * 128) = pack8(v0, v1); }
                        ss += __shfl_xor(ss, 16); ss += __shfl_xor(ss, 32);
                        if (fq == 0) atomicAdd((kind == K_QLAT ? P.ssq_q_() : P.ssq_kv_()) + row, ss);
                    } else if (kind == K_U) {
#pragma unroll
                        for (int bj = 0; bj < 2; ++bj) { const f32x4 v0 = acc[ai][bj][m][0] * rs, v1 = acc[ai][bj][m][1] * rs;
                            const int chan = (u.pn - 4) * 256 + bj * 128 + c8;
                            if (u.pm < 32) { const int b = row >> 12, i = row & 4095, c = i >> 4, s = i & 15, g = chan >> 4, p0 = chan & 15;
                                *(u32x4*)(P.ua_() + ((size_t)(g * 512 + b * 256 + c) * KY + s * 16 + p0)) = pack8(v0, v1); }
                            else if (rt < NMETA) { *(f32x4*)(P.umeta_() + rt * 1024 + chan) = v0; *(f32x4*)(P.umeta_() + rt * 1024 + chan + 4) = v1; } }
                    } else if (kind == K_GATES) {
#pragma unroll
                        for (int bj = 0; bj < 2; ++bj) { f32x4 v0 = acc[ai][bj][m][0] * rs, v1 = acc[ai][bj][m][1] * rs;
#pragma unroll
                            for (int j = 0; j < 4; ++j) { v0[j] = fast_sigmoid(v0[j]); v1[j] = fast_sigmoid(v1[j]); }
                            *(u32x4*)(P.sg_() + (size_t)row * 4096 + (u.pn - 8) * 256 + bj * 128 + c8) = pack8(v0, v1); }
                    } else {
                        if (wc < 2) { const int jp = wc * 4 + fq; const bool real = u.pm < 32; const int pos = real ? NMETA + (row & 4095) : rt;
                            if (real || rt < NMETA) {
                                const f32x4 x1 = acc[ai][0][m][0] * rs, x2 = acc[ai][0][m][1] * rs;
                                const f32x4 cs0 = *(const f32x4*)(P.cs_() + (size_t)pos * 32 + jp * 4), cs1 = *(const f32x4*)(P.cs_() + (size_t)pos * 32 + jp * 4 + 2);
                                const f32x4 cc = {cs0[0], cs0[2], cs1[0], cs1[2]}, sn = {cs0[1], cs0[3], cs1[1], cs1[3]};
                                const f32x4 o1 = x1 * cc - x2 * sn, o2 = x2 * cc + x1 * sn;
                                u32x2 w1, w2; w1.x = cvt_pk_bf16(o1[0], o1[1]); w1.y = cvt_pk_bf16(o1[2], o1[3]); w2.x = cvt_pk_bf16(o2[0], o2[1]); w2.y = cvt_pk_bf16(o2[2], o2[3]);
                                if (real) { bf16* d = P.kr_() + ((size_t)(row >> 12) * LPAD + pos) * 64 + jp * 4; *(u32x2*)d = w1; *(u32x2*)(d + 32) = w2; }
                                else { bf16* d = P.kr_() + (size_t)pos * 64 + jp * 4; *(u32x2*)d = w1; *(u32x2*)(d + 32) = w2; d += (size_t)LPAD * 64; *(u32x2*)d = w1; *(u32x2*)(d + 32) = w2; } } }
                    }
                } else if constexpr (PH == 2) {
                    if (kind == K_QN) {
                        const float sc = rsqrtf(P.ssq_q_()[row] * (1.0f / 512.0f) + EPS) * QSCALE; const int b = row >> 12, i = row & 4095;
#pragma unroll
                        for (int bj = 0; bj < 2; ++bj) { const int h = u.pn * 2 + bj;
                            *(u32x4*)(P.q_() + ((size_t)(b * NH + h) * SEQ + i) * DQK + c8) = pack8(acc[ai][bj][m][0] * sc, acc[ai][bj][m][1] * sc); }
                    } else if (kind == K_QR) {
                        const float sc = rsqrtf(P.ssq_q_()[row] * (1.0f / 512.0f) + EPS) * QSCALE; const int b = row >> 12, i = row & 4095, pos = NMETA + i;
                        const int jp = (wc & 1) * 4 + fq;
                        const f32x4 cs0 = *(const f32x4*)(P.cs_() + (size_t)pos * 32 + jp * 4), cs1 = *(const f32x4*)(P.cs_() + (size_t)pos * 32 + jp * 4 + 2);
                        const f32x4 cc = {cs0[0], cs0[2], cs1[0], cs1[2]}, sn = {cs0[1], cs0[3], cs1[1], cs1[3]};
#pragma unroll
                        for (int bj = 0; bj < 2; ++bj) { const int h = (u.pn - 8) * 4 + bj * 2 + (wc >> 1);
                            const f32x4 x1 = acc[ai][bj][m][0] * sc, x2 = acc[ai][bj][m][1] * sc; const f32x4 o1 = x1 * cc - x2 * sn, o2 = x2 * cc + x1 * sn;
                            u32x2 w1, w2; w1.x = cvt_pk_bf16(o1[0], o1[1]); w1.y = cvt_pk_bf16(o1[2], o1[3]); w2.x = cvt_pk_bf16(o2[0], o2[1]); w2.y = cvt_pk_bf16(o2[2], o2[3]);
                            bf16* d = P.q_() + ((size_t)(b * NH + h) * SEQ + i) * DQK + DNOPE + jp * 4; *(u32x2*)d = w1; *(u32x2*)(d + 32) = w2; }
                    } else if (kind == K_KV) {
                        const float sc = rsqrtf(P.ssq_kv_()[row] * (1.0f / 512.0f) + EPS); const int h = u.pn; const bool real = u.pm < 32;
                        if (real || rt < NMETA) { const int b = real ? (row >> 12) : 0, pos = real ? NMETA + (row & 4095) : rt;
#pragma unroll
                            for (int bj = 0; bj < 2; ++bj) { const u32x4 w = pack8(acc[ai][bj][m][0] * sc, acc[ai][bj][m][1] * sc);
                                bf16* d = (bj == 0 ? P.kn_() : P.v_()) + ((size_t)(b * NH + h) * LPAD + pos) * 128 + c8; *(u32x4*)d = w;
                                if (!real) *(u32x4*)(d + (size_t)NH * LPAD * 128) = w; } }
                    } else {
                        float* d = P.sloc_() + ((size_t)(u.aux * 512 + row) * 128 + c8);
                        *(f32x4*)d = acc[ai][0][m][0]; *(f32x4*)(d + 4) = acc[ai][0][m][1];
                    }
                } else if constexpr (PH == 4) {
#pragma unroll
                    for (int bj = 0; bj < 2; ++bj) { f32x4 v0 = acc[ai][bj][m][0], v1 = acc[ai][bj][m][1];
#pragma unroll
                        for (int j = 0; j < 4; ++j) { v0[j] = gelu_tanh(v0[j]); v1[j] = gelu_tanh(v1[j]); }
                        const int t = bj * 8 + wc * 2 + (fq >> 1), p0 = (fq & 1) * 8; const int tok = u.pm * SEQ + rt * TC + t;
                        *(u32x4*)(P.y_() + (size_t)tok * SSMW + u.aux * 16 + p0) = pack8(v0, v1); }
                } else if constexpr (PH == 5) {
                    const int col = u.pn * 128 + c8;
                    f32x4 g0, g1; unpack8(*(const u32x4*)(P.sg_() + (size_t)row * 4096 + 2048 + col), g0, g1);
                    f32x4 v0 = acc[ai][0][m][0], v1 = acc[ai][0][m][1]; const f32x4 t0 = acc[ai][1][m][0], t1 = acc[ai][1][m][1];
#pragma unroll
                    for (int j = 0; j < 4; ++j) { v0[j] = v0[j] * fast_sigmoid(t0[j]) * g0[j]; v1[j] = v1[j] * fast_sigmoid(t1[j]) * g1[j]; }
                    *(u32x4*)(P.pbuf_() + (size_t)row * DM + col) = pack8(v0, v1);
                } else if constexpr (PH == 6) {
#pragma unroll
                    for (int bj = 0; bj < 2; ++bj) { const int col = u.pn * 256 + bj * 128 + c8;
                        f32x4 g0, g1, p0, p1; unpack8(*(const u32x4*)(P.sg_() + (size_t)row * 4096 + col), g0, g1); unpack8(*(const u32x4*)(P.pbuf_() + (size_t)row * DM + col), p0, p1);
                        *(u32x4*)(P.mixed_() + (size_t)row * DM + col) = pack8(acc[ai][bj][m][0] * g0 + p0, acc[ai][bj][m][1] * g1 + p1); }
                } else if constexpr (PH == 7) {
                    float ss = 0.f;
#pragma unroll
                    for (int bj = 0; bj < 2; ++bj) { const int col = u.pn * 256 + bj * 128 + c8; const size_t off = (size_t)row * DM + col;
                        const f32x4 v0 = acc[ai][bj][m][0] + *(const f32x4*)(P.x_() + off), v1 = acc[ai][bj][m][1] + *(const f32x4*)(P.x_() + off + 4);
                        ss += (v0[0] * v0[0] + v0[1] * v0[1]) + (v0[2] * v0[2] + v0[3] * v0[3]) + (v1[0] * v1[0] + v1[1] * v1[1]) + (v1[2] * v1[2] + v1[3] * v1[3]);
                        *(f32x4*)(P.out_() + off) = v0; *(f32x4*)(P.out_() + off + 4) = v1; *(u32x4*)(P.h1b_() + off) = pack8(v0, v1); }
                    ss += __shfl_xor(ss, 16); ss += __shfl_xor(ss, 32);
                    if (fq == 0) atomicAdd(P.ssq_h1_() + row, ss);
                } else if constexpr (PH == 8) {
                    const float rs = rsqrtf(P.ssq_h1_()[row] * (1.0f / 2048.0f) + EPS);
                    f32x4 g0 = acc[ai][0][m][0] * rs, g1 = acc[ai][0][m][1] * rs; const f32x4 u0 = acc[ai][1][m][0] * rs, u1 = acc[ai][1][m][1] * rs;
#pragma unroll
                    for (int j = 0; j < 4; ++j) { g0[j] = g0[j] * fast_sigmoid(g0[j]) * u0[j]; g1[j] = g1[j] * fast_sigmoid(g1[j]) * u1[j]; }
                    *(u32x4*)(P.f_() + (size_t)row * DFF + u.pn * 128 + c8) = pack8(g0, g1);
                } else if constexpr (PH == 9) {
                    float ss = 0.f;
#pragma unroll
                    for (int bj = 0; bj < 2; ++bj) { const size_t off = (size_t)row * DM + u.pn * 256 + bj * 128 + c8;
                        const f32x4 v0 = acc[ai][bj][m][0] + *(const f32x4*)(P.out_() + off), v1 = acc[ai][bj][m][1] + *(const f32x4*)(P.out_() + off + 4);
                        ss += (v0[0] * v0[0] + v0[1] * v0[1]) + (v0[2] * v0[2] + v0[3] * v0[3]) + (v1[0] * v1[0] + v1[1] * v1[1]) + (v1[2] * v1[2] + v1[3] * v1[3]);
                        *(f32x4*)(P.out_() + off) = v0; *(f32x4*)(P.out_() + off + 4) = v1; }
                    ss += __shfl_xor(ss, 16); ss += __shfl_xor(ss, 32);
                    if (fq == 0) atomicAdd(P.ssq_h2_() + row, ss);
                }
            }
    }
};

template <int PH> struct Sched {
    const Ptrs& P; int G, c;
    __device__ __forceinline__ Sched(const Ptrs& p, int g, int c_) : P(p), G(g), c(c_) {}
    __device__ __forceinline__ bool next(int i, Unit& u) const {
        int L = i * G + c; u.aux = 0;
        if constexpr (PH == 1) {
            if (L < 800) { pg8::tile_order(L, 32, 25, u.pm, u.pn); }
            else { L -= 800; if (L >= 7) return false; u.pm = 32; u.pn = (L < 6) ? L + 2 : 24; }
            u.A = (const char*)P.xb_() + (size_t)u.pm * 256 * 4096; u.B = (const char*)P.win_() + (size_t)u.pn * 256 * 4096; u.lda = 4096; u.ldb = 4096; u.nt = 32;
            u.kind = u.pn < 2 ? K_QLAT : u.pn < 4 ? K_KVLAT : u.pn < 8 ? K_U : u.pn < 24 ? K_GATES : K_KR; return true;
        } else if constexpr (PH == 2) {
            if (L < 128) { const int g = L >> 1; u.pm = L & 1; u.pn = 0; u.aux = g; u.kind = K_SLOC; u.A = (const char*)P.ua_() + (size_t)(g * 512 + u.pm * 256) * (KY * 2); u.B = (const char*)P.bts_() + (size_t)g * 128 * (KS * 2);
                u.lda = KY * 2; u.ldb = KS * 2; u.nt = KS / 64; return true; }
            L -= 128;
            if (L < 528) { pg8::tile_order(L, 33, 16, u.pm, u.pn); u.kind = K_KV; u.A = (const char*)P.kvlat_() + (size_t)u.pm * 256 * 1024; u.B = (const char*)P.wkv_() + (size_t)u.pn * 256 * 1024; u.lda = 1024; u.ldb = 1024; u.nt = 8; return true; }
            L -= 528;
            if (L < 384) { pg8::tile_order(L, 32, 12, u.pm, u.pn); u.kind = u.pn < 8 ? K_QN : K_QR; u.A = (const char*)P.qlat_() + (size_t)u.pm * 256 * 1024; u.B = (const char*)P.wq_() + (size_t)u.pn * 256 * 1024; u.lda = 1024; u.ldb = 1024; u.nt = 8; return true; }
            return false;
        } else if constexpr (PH == 4) {
            if (L >= 128) return false; const int g = L >> 1; u.pm = L & 1; u.pn = 0; u.aux = g; u.kind = K_Y;
            u.A = (const char*)P.ua_() + (size_t)(g * 512 + u.pm * 256) * (KY * 2); u.B = (const char*)P.bty_() + (size_t)g * 256 * (KY * 2); u.lda = KY * 2; u.ldb = KY * 2; u.nt = KY / 64; return true;
        } else if constexpr (PH == 5) {
            if (L >= 32 * 16) return false; pg8::tile_order(L, 32, 16, u.pm, u.pn); u.kind = K_GLU;
            u.A = (const char*)P.y_() + (size_t)u.pm * 256 * 2048; u.B = (const char*)P.wglu_() + (size_t)u.pn * 256 * 2048; u.lda = 2048; u.ldb = 2048; u.nt = 16; return true;
        } else if constexpr (PH == 6 || PH == 7) {
            if (L >= 32 * 8) return false; pg8::tile_order(L, 32, 8, u.pm, u.pn); u.kind = PH == 6 ? K_AP : K_OUT;
            u.A = (const char*)(PH == 6 ? P.o_() : P.mixed_()) + (size_t)u.pm * 256 * 4096; u.B = (const char*)(PH == 6 ? P.wap_() : P.wout_()) + (size_t)u.pn * 256 * 4096; u.lda = 4096; u.ldb = 4096; u.nt = 32; return true;
        } else if constexpr (PH == 8) {
            if (L >= 32 * 44) return false; pg8::tile_order(L, 32, 44, u.pm, u.pn); u.kind = K_FFN;
            u.A = (const char*)P.h1b_() + (size_t)u.pm * 256 * 4096; u.B = (const char*)P.wffn_() + (size_t)u.pn * 256 * 4096; u.lda = 4096; u.ldb = 4096; u.nt = 32; return true;
        } else {
            if (L >= 32 * 8) return false; pg8::tile_order(L, 32, 8, u.pm, u.pn); u.kind = K_DOWN;
            u.A = (const char*)P.f_() + (size_t)u.pm * 256 * (DFF * 2); u.B = (const char*)P.wdown_() + (size_t)u.pn * 256 * (DFF * 2); u.lda = DFF * 2; u.ldb = DFF * 2; u.nt = DFF / 64; return true;
        }
    }
};

namespace att {
constexpr int QBLK = 32, KVBLK = 64, QB = 256;
constexpr int SHM_V = 16384, SHM_K = 16384, SHM_R = 8192;
constexpr int OFF_V = 0, OFF_K = 2 * SHM_V, OFF_R = OFF_K + 2 * SHM_K, OFF_WS = OFF_R + 2 * SHM_R;
constexpr float THRL = 8.f;
#define KSWZ(row, colB) ((row) * 256 + ((colB) ^ (((row) & 7) << 4)))
#define RSWZ(row, chunk) ((row) * 128 + ((((chunk) ^ (row)) & 7) << 4))
__device__ __forceinline__ int v_st(int k, int c) { const int kk = (k & ~0xC) | ((k & 4) << 1) | ((k & 8) >> 1); return ((kk >> 3) * 4 + (c >> 5)) * 512 + ((kk & 7) * 32 + (c & 31)) * 2; }
__device__ __forceinline__ int v_rd_base(int lane) { return ((lane & 3) << 3) | (((lane >> 2) & 3) << 6) | (((lane >> 4) & 1) << 5) | (((lane >> 5) & 1) << 8); }
constexpr int v_rd_off(int d0, int ks, int half) { return d0 * 512 + ks * 4096 + half * 2048; }
__device__ __forceinline__ int crow(int r, int hi) { return (r & 3) + 8 * (r >> 2) + 4 * hi; }

template <int KB>
__device__ __forceinline__ void qkt(f32x16& p0, f32x16& p1, LAS const char* lds, int r32, int hi, const bf16x8* qr) {
    p0 = f32x16{}; p1 = f32x16{};
    LAS const char* kb[4];
#pragma unroll
    for (int dd = 0; dd < 4; ++dd) kb[dd] = lds + OFF_K + KB * SHM_K + KSWZ(r32, (dd * 16 + hi * 8) * 2);
#pragma unroll
    for (int d0 = 0; d0 < 8; ++d0) { LAS const char* a = kb[d0 & 3] + (d0 >> 2) * 128;
        const bf16x8 b0 = *(LAS const bf16x8*)(a); const bf16x8 b1 = *(LAS const bf16x8*)(a + 32 * 256);
        p0 = __builtin_amdgcn_mfma_f32_32x32x16_bf16(b0, qr[d0], p0, 0, 0, 0);
        p1 = __builtin_amdgcn_mfma_f32_32x32x16_bf16(b1, qr[d0], p1, 0, 0, 0); }
#pragma unroll
    for (int d0 = 0; d0 < 4; ++d0) { LAS const char* a = lds + OFF_R + KB * SHM_R + RSWZ(r32, d0 * 2 + hi);
        const bf16x8 b0 = *(LAS const bf16x8*)(a); const bf16x8 b1 = *(LAS const bf16x8*)(a + 32 * 128);
        p0 = __builtin_amdgcn_mfma_f32_32x32x16_bf16(b0, qr[8 + d0], p0, 0, 0, 0);
        p1 = __builtin_amdgcn_mfma_f32_32x32x16_bf16(b1, qr[8 + d0], p1, 0, 0, 0); }
}
template <int VB>
__device__ __forceinline__ void pv_tile(f32x16* o, int vb0, bf16x8 pa0, bf16x8 pa1, bf16x8 pa2, bf16x8 pa3) {
#define TRRD(dst, off) asm volatile("ds_read_b64_tr_b16 %0, %1 offset:%2" : "=&v"(dst) : "v"(vb0), "i"(off) : "memory")
#define PV_D0(d0) do { s16x4 l0, l1, l2, l3, h0, h1, h2, h3; constexpr int b_ = OFF_V + VB * SHM_V + v_rd_off(d0, 0, 0); \
        TRRD(l0, b_); TRRD(h0, b_ + 2048); TRRD(l1, b_ + 4096); TRRD(h1, b_ + 6144); TRRD(l2, b_ + 8192); TRRD(h2, b_ + 10240); TRRD(l3, b_ + 12288); TRRD(h3, b_ + 14336); \
        asm volatile("s_waitcnt lgkmcnt(0)" ::: "memory"); SBAR(); \
        o[d0] = __builtin_amdgcn_mfma_f32_32x32x16_bf16(pa0, (bf16x8){l0[0], l0[1], l0[2], l0[3], h0[0], h0[1], h0[2], h0[3]}, o[d0], 0, 0, 0); \
        o[d0] = __builtin_amdgcn_mfma_f32_32x32x16_bf16(pa1, (bf16x8){l1[0], l1[1], l1[2], l1[3], h1[0], h1[1], h1[2], h1[3]}, o[d0], 0, 0, 0); \
        o[d0] = __builtin_amdgcn_mfma_f32_32x32x16_bf16(pa2, (bf16x8){l2[0], l2[1], l2[2], l2[3], h2[0], h2[1], h2[2], h2[3]}, o[d0], 0, 0, 0); \
        o[d0] = __builtin_amdgcn_mfma_f32_32x32x16_bf16(pa3, (bf16x8){l3[0], l3[1], l3[2], l3[3], h3[0], h3[1], h3[2], h3[3]}, o[d0], 0, 0, 0); } while (0)
    PV_D0(0); PV_D0(1); PV_D0(2); PV_D0(3);
#undef PV_D0
#undef TRRD
}
__device__ __forceinline__ void attn_block(const Ptrs& P, int b, int h, int qb, LAS char* lds) {
    const int tid = threadIdx.x, wid = __builtin_amdgcn_readfirstlane(tid >> 6), lane = tid & 63, r32 = lane & 31, hi = lane >> 5;
    const int i0 = qb * QB, P0 = NMETA + i0;
    const int NT = (P0 + QB - 1) / KVBLK + 1;
    const bf16* Qw = P.q_() + ((size_t)(b * NH + h) * SEQ + i0 + wid * QBLK + r32) * DQK;
    const __amdgpu_buffer_rsrc_t srdK = __builtin_amdgcn_make_buffer_rsrc((void*)(P.kn_() + (size_t)(b * NH + h) * LPAD * 128), (short)0, LPAD * 256, 0x00020000);
    const __amdgpu_buffer_rsrc_t srdV = __builtin_amdgcn_make_buffer_rsrc((void*)(P.v_() + (size_t)(b * NH + h) * LPAD * 128), (short)0, LPAD * 256, 0x00020000);
    const __amdgpu_buffer_rsrc_t srdR = __builtin_amdgcn_make_buffer_rsrc((void*)(P.kr_() + (size_t)b * LPAD * 64), (short)0, LPAD * 128, 0x00020000);
    bf16x8 qr[12];
#pragma unroll
    for (int d0 = 0; d0 < 12; ++d0) qr[d0] = *(const bf16x8*)(Qw + d0 * 16 + hi * 8);
    const int sr = tid >> 4, sc = (tid & 15) * 8, kws = KSWZ(sr, sc * 2), vst0 = v_st(sr, sc), vst1 = v_st(32 + sr, sc);
    const int rr = tid >> 3, rc = tid & 7, rws = RSWZ(rr, rc);
    const int qlo = P0 + wid * QBLK, qm = qlo + r32 - 4 * hi;
    LAS float* wsf = (LAS float*)(lds + OFF_WS) + wid * 64; LAS float* li_l = wsf; LAS float* al_l = wsf + 32;
    const int vb0 = (int)(uintptr_t)(lds) + v_rd_base(lane);
    float m_reg = -1e30f, l_reg = 0.f; f32x16 o[4] = {};
    bf16x8 st_k0, st_k1, st_v0, st_v1, st_r;
    const unsigned gofk = (unsigned)((tid >> 4) * 128 + (tid & 15) * 8) * 2u, gofr = (unsigned)((tid >> 3) * 64 + (tid & 7) * 8) * 2u;
#define BLD(rsrc, vo, so) __builtin_bit_cast(bf16x8, __builtin_amdgcn_raw_buffer_load_b128(rsrc, vo, so, 0))
#define SLOAD(t) do { const int so_ = (t) * (KVBLK * 256); \
        st_k0 = BLD(srdK, gofk, so_); st_k1 = BLD(srdK, gofk, so_ + 8192); st_v0 = BLD(srdV, gofk, so_); st_v1 = BLD(srdV, gofk, so_ + 8192); st_r = BLD(srdR, gofr, (t) * (KVBLK * 128)); } while (0)
#define SWRITE(bf) do { *(LAS bf16x8*)(lds + OFF_K + (bf) * SHM_K + kws) = st_k0; *(LAS bf16x8*)(lds + OFF_K + (bf) * SHM_K + kws + 32 * 256) = st_k1; \
        *(LAS bf16x8*)(lds + OFF_V + (bf) * SHM_V + vst0) = st_v0; *(LAS bf16x8*)(lds + OFF_V + (bf) * SHM_V + vst1) = st_v1; *(LAS bf16x8*)(lds + OFF_R + (bf) * SHM_R + rws) = st_r; } while (0)
    SLOAD(0); SWRITE(0);
    if (NT > 1) SLOAD(1);
    __syncthreads();
    f32x16 p0, p1; bf16x8 pa0, pa1, pa2, pa3;
#define STEP(t, BUF) do { \
        SBAR(); qkt<BUF>(p0, p1, lds, r32, hi, qr); \
        { const int kb_ = (t) * KVBLK; if (kb_ + KVBLK - 1 > qlo) { const int dq = qm - kb_; const float NEG = -__builtin_inff(); \
            _Pragma("unroll") for (int r = 0; r < 16; ++r) { const int c_ = (r & 3) + 8 * (r >> 2); if (dq - c_ < 0) p0[r] = NEG; if (dq - c_ - 32 < 0) p1[r] = NEG; } } } \
        float pmax = p0[0]; _Pragma("unroll") for (int r = 1; r < 16; ++r) pmax = fmaxf(pmax, p0[r]); _Pragma("unroll") for (int r = 0; r < 16; ++r) pmax = fmaxf(pmax, p1[r]); \
        { auto sw_ = __builtin_amdgcn_permlane32_swap(__float_as_uint(pmax), __float_as_uint(pmax), false, false); pmax = fmaxf(__uint_as_float(sw_[0]), __uint_as_float(sw_[1])); } \
        float alpha = 1.f; \
        if (!__all(pmax - m_reg <= THRL)) { const float mn = fmaxf(m_reg, pmax); alpha = __builtin_amdgcn_exp2f(m_reg - mn); m_reg = mn; } \
        _Pragma("unroll") for (int r = 0; r < 16; ++r) { p0[r] = __builtin_amdgcn_exp2f(p0[r] - m_reg); p1[r] = __builtin_amdgcn_exp2f(p1[r] - m_reg); } \
        float ps = 0.f; _Pragma("unroll") for (int r = 0; r < 16; ++r) ps += p0[r]; _Pragma("unroll") for (int r = 0; r < 16; ++r) ps += p1[r]; \
        { auto sw_ = __builtin_amdgcn_permlane32_swap(__float_as_uint(ps), __float_as_uint(ps), false, false); ps = __uint_as_float(sw_[0]) + __uint_as_float(sw_[1]); } \
        l_reg = l_reg * alpha + ps; \
        PK4(p0, 0, pa0); PK4(p0, 8, pa1); PK4(p1, 0, pa2); PK4(p1, 8, pa3); \
        if (__any(alpha < 1.f)) { if (hi == 0) al_l[r32] = alpha; asm volatile("s_waitcnt lgkmcnt(0)" ::: "memory"); \
            _Pragma("unroll") for (int d_ = 0; d_ < 4; ++d_) _Pragma("unroll") for (int r = 0; r < 16; ++r) o[d_][r] *= al_l[crow(r, hi)]; } \
        SBAR(); pv_tile<BUF>(o, vb0, pa0, pa1, pa2, pa3); SBAR(); \
        if ((t) + 1 < NT) SWRITE((BUF) ^ 1); \
        __syncthreads(); \
        if ((t) + 2 < NT) SLOAD((t) + 2); } while (0)
#define PK4(Pv, B_, OUT) do { const unsigned a0 = cvt_pk_bf16(Pv[B_ + 0], Pv[B_ + 1]), a1 = cvt_pk_bf16(Pv[B_ + 2], Pv[B_ + 3]), b0 = cvt_pk_bf16(Pv[B_ + 4], Pv[B_ + 5]), b1 = cvt_pk_bf16(Pv[B_ + 6], Pv[B_ + 7]); \
        auto r0 = __builtin_amdgcn_permlane32_swap(a0, b0, false, false); auto r1 = __builtin_amdgcn_permlane32_swap(a1, b1, false, false); \
        u32x4 w_ = {r0[0], r1[0], r0[1], r1[1]}; OUT = *reinterpret_cast<bf16x8*>(&w_); } while (0)
    int t = 0;
    for (; t + 1 < NT; t += 2) { STEP(t, 0); STEP(t + 1, 1); }
    if (t < NT) STEP(t, 0);
#undef STEP
#undef PK4
#undef SLOAD
#undef BLD
#undef SWRITE
    if (hi == 0) li_l[r32] = l_reg; asm volatile("s_waitcnt lgkmcnt(0)" ::: "memory");
    float rli[16];
#pragma unroll
    for (int r = 0; r < 16; ++r) rli[r] = __builtin_amdgcn_rcpf(li_l[crow(r, hi)]);
    bf16* Ow = P.o_() + ((size_t)(b * SEQ + i0 + wid * QBLK)) * DM + h * DV;
#pragma unroll
    for (int r = 0; r < 16; ++r) { const int orow = crow(r, hi);
#pragma unroll
        for (int d0 = 0; d0 < 4; ++d0) { const float v = o[d0][r] * rli[r]; const float vn = __shfl_xor(v, 1);
            if ((r32 & 1) == 0) *(unsigned*)(Ow + (size_t)orow * DM + d0 * 32 + r32) = cvt_pk_bf16(v, vn); } }
    __syncthreads();
}
#undef KSWZ
#undef RSWZ
}

#define XB_TMO      128
#define XB_XCNT(j)  (256  + 64 * (j))
#define XB_XSUB(j)  (1280 + 64 * (j))
#define XB_XGEN(j)  (2304 + 64 * (j))
#define XB_TOP      3328
#define XB_TOPGEN   3392
#define XCD_BAR_WORDS 3456
#define XB_SPIN_CAP (1u << 18)
__device__ __forceinline__ unsigned xb_ld(unsigned* p)              { return __hip_atomic_load(p, __ATOMIC_RELAXED, __HIP_MEMORY_SCOPE_AGENT); }
__device__ __forceinline__ unsigned xb_add(unsigned* p, unsigned v) { return __hip_atomic_fetch_add(p, v, __ATOMIC_RELAXED, __HIP_MEMORY_SCOPE_AGENT); }
__device__ __forceinline__ unsigned xb_xcc_id() { return (unsigned)__builtin_amdgcn_s_getreg((3 << 11) | 20) & 0xFu; }
#define XB_SPIN(cond, bar) do { unsigned _sp = 0; while (cond) { __builtin_amdgcn_s_sleep(1); \
    if ((++_sp & 255u) == 0u) { if (xb_ld(&(bar)[XB_TMO])) break; if (_sp > XB_SPIN_CAP) { atomicAdd(&(bar)[XB_TMO], 1u); break; } } } } while (0)
struct XcdBarrier { unsigned* bar; unsigned x; volatile LAS unsigned* st; };
__device__ __forceinline__ XcdBarrier xcd_barrier_post(unsigned* bar, volatile LAS unsigned* st) {
    XcdBarrier b; b.bar = bar; b.x = xb_xcc_id(); b.st = st;
    if (threadIdx.x == 0) (void)xb_add(&bar[XB_XCNT(b.x)], 1u);
    return b;
}
__device__ __forceinline__ void xcd_barrier_complete(unsigned* bar, unsigned x, unsigned& nloc, unsigned& nx) {
    const unsigned G = gridDim.x * gridDim.y * gridDim.z;
    unsigned sum, cnt, mine, sp = 0u;
    for (;;) {
        sum = 0u; cnt = 0u; mine = 0u;
#pragma unroll
        for (unsigned j = 0; j < 16; ++j) { const unsigned c = xb_ld(&bar[XB_XCNT(j)]); sum += c; cnt += (c > 0u) ? 1u : 0u; mine = (j == x) ? c : mine; }
        if (sum == G) break;
        __builtin_amdgcn_s_sleep(1);
        if ((++sp & 255u) == 0u) { if (xb_ld(&bar[XB_TMO])) break; if (sp > XB_SPIN_CAP) { atomicAdd(&bar[XB_TMO], 1u); break; } }
    }
    nloc = mine > 0u ? mine : 1u; nx = cnt > 0u ? cnt : 1u;
}
__device__ __forceinline__ void xcd_barrier(const XcdBarrier& b) {
    asm volatile("s_waitcnt vmcnt(0)" ::: "memory");
    __syncthreads();
    if (threadIdx.x == 0) {
        unsigned* bar = b.bar;
        __builtin_amdgcn_s_waitcnt(0);
        unsigned nloc = b.st[0], nx = b.st[1];
        if (nloc == 0u) { xcd_barrier_complete(bar, b.x, nloc, nx); b.st[0] = nloc; b.st[1] = nx; }
        const unsigned old = xb_add(&bar[XB_XSUB(b.x)], 1u);
        const unsigned gen = old / nloc;
        if (old + 1u == (gen + 1u) * nloc) {
            __builtin_amdgcn_fence(__ATOMIC_RELEASE, "agent");
            asm volatile("s_waitcnt vmcnt(0)" ::: "memory");
            const unsigned og = xb_add(&bar[XB_TOP], 1u);
            const unsigned tg = og / nx;
            if (og + 1u == (tg + 1u) * nx) xb_add(&bar[XB_TOPGEN], 1u);
            else XB_SPIN(xb_ld(&bar[XB_TOPGEN]) == tg, bar);
            __builtin_amdgcn_fence(__ATOMIC_ACQUIRE, "agent");
            xb_add(&bar[XB_XGEN(b.x)], 1u);
            asm volatile("s_waitcnt vmcnt(0)" ::: "memory");
        } else {
            XB_SPIN(xb_ld(&bar[XB_XGEN(b.x)]) == gen, bar);
            __builtin_amdgcn_fence(__ATOMIC_ACQUIRE, "agent");
            asm volatile("s_waitcnt vmcnt(0)" ::: "memory");
        }
    }
    __syncthreads();
}

enum { J_WIN = 0, J_WQ, J_WKV, J_WGLU, J_WAP, J_WOUT, J_WFFN, J_WDOWN };
struct ConvSrc { const float* p; };
template <int JOB> __device__ __forceinline__ const float* conv_src(const Ptrs& P, int r) {
    if constexpr (JOB == J_WIN) {
        if (r < 1024) return P.w_in_() + r;
        if (r < 2048) return P.w_in_() + 1088 + (r - 1024);
        if (r < 6144) return P.w_in_() + 2112 + (r - 2048);
        if (r < 6208) { const int rr = r - 6144, jp = rr >> 3, n = (rr >> 2) & 1, j = rr & 3; return P.w_in_() + 1024 + n * 32 + jp * 4 + j; }
        return nullptr;
    } else if constexpr (JOB == J_WQ) {
        if (r < 2048) return P.w_q_up_() + (r >> 7) * 192 + (r & 127);
        const int rr = r - 2048, h = rr >> 6, w = rr & 63, jp = w >> 3, n = (w >> 2) & 1, j = w & 3; return P.w_q_up_() + h * 192 + 128 + n * 32 + jp * 4 + j;
    } else if constexpr (JOB == J_WKV) { return P.w_kv_up_() + r;
    } else if constexpr (JOB == J_WGLU) { const int t = r >> 8, bj = (r >> 7) & 1, c = r & 127; return (bj ? P.w_glu_gate_() : P.w_glu_val_()) + t * 128 + c;
    } else if constexpr (JOB == J_WAP) { return P.w_attn_proj_() + r;
    } else if constexpr (JOB == J_WOUT) { return P.w_out_() + r;
    } else if constexpr (JOB == J_WFFN) { const int t = r >> 8, bj = (r >> 7) & 1, c = r & 127; return (bj ? P.w_ffn_up_() : P.w_ffn_gate_()) + t * 128 + c;
    } else { return P.w_ffn_down_() + r; }
}
template <int JOB> __device__ __forceinline__ void conv_item(const Ptrs& P, int item, LAS float* scr, int lane) {
    constexpr int K = (JOB == J_WIN || JOB == J_WAP || JOB == J_WOUT || JOB == J_WFFN) ? 2048 : (JOB == J_WQ || JOB == J_WKV) ? 512 : (JOB == J_WGLU) ? 1024 : 5632;
    constexpr int NOUT = (JOB == J_WIN) ? NWIN : (JOB == J_WQ) ? 3072 : (JOB == J_WKV || JOB == J_WGLU) ? 4096 : (JOB == J_WFFN) ? 11264 : 2048;
    constexpr int LDS_ = (JOB == J_WIN) ? INW : (JOB == J_WQ) ? 3072 : (JOB == J_WKV) ? 4096 : (JOB == J_WGLU || JOB == J_WAP || JOB == J_WOUT || JOB == J_WDOWN) ? 2048 : 5632;
    const float* gain = (JOB == J_WIN) ? P.norm_mix_() : (JOB == J_WQ) ? P.norm_q_() : (JOB == J_WKV) ? P.norm_kv_() : (JOB == J_WFFN) ? P.norm_ffn_() : nullptr;
    bf16* WT = (JOB == J_WIN) ? P.win_() : (JOB == J_WQ) ? P.wq_() : (JOB == J_WKV) ? P.wkv_() : (JOB == J_WGLU) ? P.wglu_() : (JOB == J_WAP) ? P.wap_() : (JOB == J_WOUT) ? P.wout_() : (JOB == J_WFFN) ? P.wffn_() : P.wdown_();
    constexpr int nblk = NOUT / 32; const int kb = item / nblk, nb = item % nblk, k0 = 64 * kb, n0 = 32 * nb;
    const float* src = conv_src<JOB>(P, n0 + (lane & 31));
#pragma unroll 8
    for (int i = 0; i < 32; ++i) { const int kk = 2 * i + (lane >> 5); float v = 0.f;
        if (src) { v = src[(size_t)(k0 + kk) * LDS_]; if (gain) v *= gain[k0 + kk]; }
        scr[kk * 33 + (lane & 31)] = v; }
    LDS_WAIT(); asm volatile("" ::: "memory");
    const int c = lane & 7;
#pragma unroll
    for (int j = 0; j < 4; ++j) { const int n = (lane >> 3) + 8 * j; const LAS float* s = scr + (8 * c) * 33 + n;
        u32x4 o; o.x = cvt_pk_bf16(s[0 * 33], s[1 * 33]); o.y = cvt_pk_bf16(s[2 * 33], s[3 * 33]); o.z = cvt_pk_bf16(s[4 * 33], s[5 * 33]); o.w = cvt_pk_bf16(s[6 * 33], s[7 * 33]);
        *(u32x4*)(WT + (size_t)(n0 + n) * K + k0 + 8 * c) = o; }
    LDS_WAIT(); asm volatile("" ::: "memory");
}
constexpr int conv_items(int K, int NOUT) { return (K / 64) * (NOUT / 32); }
__device__ __forceinline__ float wave_sum(float v) {
#pragma unroll
    for (int o = 1; o < 64; o <<= 1) v += __shfl_xor(v, o);
    return v;
}
__device__ __forceinline__ void ssm_build(const Ptrs& P, int g, LAS unsigned char* lds) {
    LAS f32x2* apw = (LAS f32x2*)lds;
    LAS f32x2* bb = (LAS f32x2*)(lds + 17 * 64 * 8);
    LAS f32x2* cc = bb + 64 * 16;
    LAS float* ktab = (LAS float*)(cc + 16 * 64);
    const int tid = threadIdx.x;
    const float step = expf(P.log_step_()[g]);
    if (tid < 64) { const int n = tid; const float lr = P.lam_re_()[g * 64 + n], li = P.lam_im_()[g * 64 + n];
        const float th = li * step, lm = lr * step;
        for (int k = 0; k <= 16; ++k) { const float mag = expf((float)k * lm); float sn, cs; sincosf((float)k * th, &sn, &cs); const f32x2 a = {mag * cs, mag * sn}; apw[k * 64 + n] = a; P.apow_()[((size_t)g * 17 + k) * 64 + n] = a; }
        const float mag1 = expf(lm); float s1, c1; sincosf(th, &s1, &c1); const float abr = mag1 * c1, abi = mag1 * s1;
        const float den = lr * lr + li * li, nr = abr - 1.0f, ni = abi; const float cr = (nr * lr + ni * li) / den, ci = (ni * lr - nr * li) / den;
        for (int q = 0; q < 16; ++q) { const float br = P.b_re_()[((size_t)g * 64 + n) * 16 + q], bi = P.b_im_()[((size_t)g * 64 + n) * 16 + q];
            const f32x2 w = {cr * br - ci * bi, cr * bi + ci * br}; bb[n * 16 + q] = w; P.bbar_()[((size_t)g * 64 + n) * 16 + q] = w; } }
    for (int e = tid; e < 1024; e += 512) { const int p = e >> 6, n = e & 63; cc[e] = (f32x2){P.c_re_()[((size_t)g * 16 + p) * 64 + n], P.c_im_()[((size_t)g * 16 + p) * 64 + n]}; }
    __syncthreads();
    for (int e = tid; e < 4096; e += 512) { const int k = e >> 8, p = (e >> 4) & 15, q = e & 15; float acc = 0.f;
        for (int n = 0; n < 64; ++n) { const f32x2 a = apw[k * 64 + n], b = bb[n * 16 + q], c = cc[p * 64 + n];
            const float wr_ = a.x * b.x - a.y * b.y, wi_ = a.x * b.y + a.y * b.x; acc += c.x * wr_ - c.y * wi_; }
        if (k == 0 && p == q) acc += P.ssm_d_()[g * 16 + p];
        ktab[e] = acc; }
    __syncthreads();
    bf16* bty = P.bty_() + (size_t)g * 256 * KY;
    for (int e = tid; e < 256 * KY / 2; e += 512) { const int row = (2 * e) / KY, col = (2 * e) % KY; const int t = row >> 4, p = row & 15; float v[2];
#pragma unroll
        for (int z = 0; z < 2; ++z) { const int cl = col + z;
            if (cl < 256) { const int s = cl >> 4, q = cl & 15; v[z] = (s <= t) ? ktab[((t - s) * 16 + p) * 16 + q] : 0.f; }
            else { const int n = (cl - 256) & 63; const f32x2 a = apw[(t + 1) * 64 + n], c = cc[p * 64 + n]; v[z] = (cl < 320) ? (c.x * a.x - c.y * a.y) : -(c.x * a.y + c.y * a.x); } }
        *(unsigned*)(bty + (size_t)row * KY + col) = cvt_pk_bf16(v[0], v[1]); }
    bf16* bts = P.bts_() + (size_t)g * 128 * KS;
    for (int e = tid; e < 128 * KS / 2; e += 512) { const int row = (2 * e) / KS, col = (2 * e) % KS; const int n = row & 63; float v[2];
#pragma unroll
        for (int z = 0; z < 2; ++z) { const int cl = col + z, s = cl >> 4, q = cl & 15; const f32x2 a = apw[(15 - s) * 64 + n], b = bb[n * 16 + q];
            v[z] = (row < 64) ? (a.x * b.x - a.y * b.y) : (a.x * b.y + a.y * b.x); }
        *(unsigned*)(bts + (size_t)row * KS + col) = cvt_pk_bf16(v[0], v[1]); }
    __syncthreads();
}

__global__ void __launch_bounds__(NWAVES * 64, 2) hybrid_fwd(Args args) {
    extern __shared__ __attribute__((aligned(16))) unsigned char lds_raw[];
    LAS unsigned char* lds = (LAS unsigned char*)lds_raw;
    volatile LAS unsigned* MISC = (volatile LAS unsigned*)(lds + MISC_OFF);
    const int tid = threadIdx.x, lane = tid & 63, wave = __builtin_amdgcn_readfirstlane(tid >> 6);
    const int G = gridDim.x; const int bx = blockIdx.x; const int vcu = (G % 8 == 0) ? (bx % 8) * (G / 8) + bx / 8 : bx;
    const Ptrs P(args);
    for (int u = tid; u < (LDS_BYTES - LDSCTL_OFF) / 4; u += NWAVES * 64) ((LAS unsigned*)(lds + LDSCTL_OFF))[u] = 0u;
    __syncthreads();
    XcdBarrier bar; bar.bar = P.ctl_() + CW_BAR; bar.x = 0; bar.st = nullptr;
    if (!MK_SPLIT) bar = xcd_barrier_post(P.ctl_() + CW_BAR, MISC + 8);
    const int lo = args.ph_lo, hi = args.ph_hi;
#define IN(k) (lo <= (k) && (k) < hi)
#define SEAM(k) do { if (IN(k) && IN((k) + 1)) xcd_barrier(bar); } while (0)
    const int gw = vcu * NWAVES + wave, NGW = G * NWAVES;
    const int gt = vcu * (NWAVES * 64) + tid, NGT = G * NWAVES * 64;

    if (IN(0)) {
        if (vcu < NG) ssm_build(P, vcu, lds);
        LAS float* scr = (LAS float*)(lds + wave * 16384);
        {
            constexpr int I0 = conv_items(2048, NWIN), I1 = conv_items(512, 3072), I2 = conv_items(512, 4096), I3 = conv_items(1024, 4096), I4 = conv_items(2048, 2048);
            for (int it = gw; it < I0 + I1 + I2 + I3 + I4; it += NGW) { int r = it;
                if (r < I0) { conv_item<J_WIN>(P, r, scr, lane); continue; } r -= I0;
                if (r < I1) { conv_item<J_WQ>(P, r, scr, lane); continue; } r -= I1;
                if (r < I2) { conv_item<J_WKV>(P, r, scr, lane); continue; } r -= I2;
                if (r < I3) { conv_item<J_WGLU>(P, r, scr, lane); continue; } r -= I3;
                conv_item<J_WAP>(P, r, scr, lane); }
        }
        for (int m = gw; m < MROWS; m += NGW) {
            GAS u32x2* o8 = (GAS u32x2*)(P.xb_() + (size_t)m * DM) + lane;
            if (m < MTOK + NMETA) { const float* xr = (m < MTOK) ? P.x_() + (size_t)m * DM : P.meta_() + (size_t)(m - MTOK) * DM;
                f32x4 v[8]; float s = 0.f;
#pragma unroll
                for (int j = 0; j < 8; ++j) { v[j] = *((const GAS f32x4*)xr + lane + 64 * j); s += (v[j][0] * v[j][0] + v[j][1] * v[j][1]) + (v[j][2] * v[j][2] + v[j][3] * v[j][3]); }
                s = wave_sum(s); if (lane == 0) P.rs1_()[m] = rsqrtf(s * (1.0f / DM) + EPS);
#pragma unroll
                for (int j = 0; j < 8; ++j) { u32x2 w; w.x = cvt_pk_bf16(v[j][0], v[j][1]); w.y = cvt_pk_bf16(v[j][2], v[j][3]); o8[64 * j] = w; } }
            else { if (lane == 0) P.rs1_()[m] = 1.0f;
#pragma unroll
                for (int j = 0; j < 8; ++j) o8[64 * j] = (u32x2){0u, 0u}; }
        }
        for (int e = gt; e < LTOT * 32; e += NGT) { const int pos = e >> 5, i = e & 31; const float fr_ = (float)pow(10000.0, -(double)i / 32.0); const float ang = (float)pos * fr_;
            P.cs_()[e] = (f32x2){(float)cos((double)ang), (float)sin((double)ang)}; }
        for (int e = gt; e < NBATCH * NH * (LPAD - LTOT) * 16; e += NGT) { const int bh = e / ((LPAD - LTOT) * 16), r = e % ((LPAD - LTOT) * 16); const size_t off = ((size_t)bh * LPAD + LTOT) * 128 + (size_t)r * 8;
            *(u32x4*)(P.kn_() + off) = (u32x4){0u, 0u, 0u, 0u}; *(u32x4*)(P.v_() + off) = (u32x4){0u, 0u, 0u, 0u}; }
        for (int e = gt; e < NBATCH * (LPAD - LTOT) * 8; e += NGT) { const int b = e / ((LPAD - LTOT) * 8), r = e % ((LPAD - LTOT) * 8); *(u32x4*)(P.kr_() + ((size_t)b * LPAD + LTOT) * 64 + (size_t)r * 8) = (u32x4){0u, 0u, 0u, 0u}; }
        for (int e = gt; e < 128 * KS / 8; e += NGT) *(u32x4*)(P.bts_() + (size_t)NG * 128 * KS + (size_t)e * 8) = (u32x4){0u, 0u, 0u, 0u};
    }
    SEAM(0);
    if (IN(1)) { Sched<1> S(P, G, bx); Epi<1> E(P); pg8::gemm_run(lds, S, E); }
    SEAM(1);
    if (IN(2)) {
        if (vcu < 8) { const int e = vcu * 512 + tid, g = e >> 6, n = e & 63; float xr = 0.f, xi = 0.f;
            for (int s = 0; s < NMETA; ++s) { const f32x2 a = P.apow_()[((size_t)g * 17 + (15 - s)) * 64 + n]; float br = 0.f, bi = 0.f;
                for (int q = 0; q < 16; ++q) { const f32x2 w = P.bbar_()[((size_t)g * 64 + n) * 16 + q]; const float uu = P.umeta_()[s * 1024 + g * 16 + q]; br += w.x * uu; bi += w.y * uu; }
                xr += a.x * br - a.y * bi; xi += a.x * bi + a.y * br; }
            P.x0_()[e] = (f32x2){xr, xi}; }
        Sched<2> S(P, G, bx); Epi<2> E(P); pg8::gemm_run(lds, S, E);
    }
    SEAM(2);
    if (IN(3)) {
        {
            const int w = vcu; const int b = w >> 7, g = (w >> 1) & 63, n = (w & 1) * 32 + (tid & 31), seg = tid >> 5;
            if (w < 256) {
                const f32x2 A16 = P.apow_()[((size_t)g * 17 + 16) * 64 + n];
                f32x2 A256 = A16;
#pragma unroll
                for (int z = 0; z < 4; ++z) A256 = (f32x2){A256.x * A256.x - A256.y * A256.y, 2.f * A256.x * A256.y};
                const float* sl = P.sloc_() + ((size_t)(g * 512 + b * 256 + seg * 16)) * 128 + n;
                float sre[16], sim[16];
#pragma unroll
                for (int j = 0; j < 16; ++j) { sre[j] = sl[j * 128]; sim[j] = sl[j * 128 + 64]; }
                float tr = 0.f, ti = 0.f;
#pragma unroll
                for (int j = 0; j < 16; ++j) { const float nr = A16.x * tr - A16.y * ti + sre[j], ni = A16.x * ti + A16.y * tr + sim[j]; tr = nr; ti = ni; }
                LAS f32x2* T = (LAS f32x2*)lds;
                T[seg * 32 + (tid & 31)] = (f32x2){tr, ti};
                __syncthreads();
                const f32x2 x0v = P.x0_()[g * 64 + n]; float xr = x0v.x, xi = x0v.y;
                for (int s2 = 0; s2 < seg; ++s2) { const f32x2 tv = T[s2 * 32 + (tid & 31)]; const float nr = A256.x * xr - A256.y * xi + tv.x, ni = A256.x * xi + A256.y * xr + tv.y; xr = nr; xi = ni; }
                bf16* ua = P.ua_() + ((size_t)(g * 512 + b * 256 + seg * 16)) * KY + 256 + n;
#pragma unroll
                for (int j = 0; j < 16; ++j) { ua[(size_t)j * KY] = (bf16)(cvt_pk_bf16(xr, 0.f) & 0xffffu); ua[(size_t)j * KY + 64] = (bf16)(cvt_pk_bf16(xi, 0.f) & 0xffffu);
                    const float nr = A16.x * xr - A16.y * xi + sre[j], ni = A16.x * xi + A16.y * xr + sim[j]; xr = nr; xi = ni; }
            }
            __syncthreads();
        }
        for (int it = vcu; it < 256; it += G) { const int bh = it >> 3, xq = it & 7;
            for (int pass = 0; pass < 2; ++pass) att::attn_block(P, bh >> 4, bh & 15, pass ? 15 - xq : xq, (LAS char*)lds); }
    }
    SEAM(3);
    if (IN(4)) {
        LAS float* scr = (LAS float*)(lds + wave * 16384);
        constexpr int I0 = conv_items(2048, 2048), I1 = conv_items(2048, 11264), I2 = conv_items(5632, 2048);
        for (int it = gw; it < I0 + I1 + I2; it += NGW) { int r = it;
            if (r < I0) { conv_item<J_WOUT>(P, r, scr, lane); continue; } r -= I0;
            if (r < I1) { conv_item<J_WFFN>(P, r, scr, lane); continue; } r -= I1;
            conv_item<J_WDOWN>(P, r, scr, lane); }
        __syncthreads();
        Sched<4> S(P, G, bx); Epi<4> E(P); pg8::gemm_run(lds, S, E);
    }
    SEAM(4);
    if (IN(5)) { Sched<5> S(P, G, bx); Epi<5> E(P); pg8::gemm_run(lds, S, E); }
    SEAM(5);
    if (IN(6)) { Sched<6> S(P, G, bx); Epi<6> E(P); pg8::gemm_run(lds, S, E); }
    SEAM(6);
    if (IN(7)) { Sched<7> S(P, G, bx); Epi<7> E(P); pg8::gemm_run(lds, S, E); }
    SEAM(7);
    if (IN(8)) { Sched<8> S(P, G, bx); Epi<8> E(P); pg8::gemm_run(lds, S, E); }
    SEAM(8);
    if (IN(9)) { Sched<9> S(P, G, bx); Epi<9> E(P); pg8::gemm_run(lds, S, E); }
    SEAM(9);
    if (IN(10)) {
        const bool bad = __hip_atomic_load(P.ctl_() + CW_BAR + XB_TMO, RLX_AGENT) != 0u;
        unsigned lane_ = threadIdx.x; asm volatile("" : "+v"(lane_)); lane_ &= 63u;
        for (int m = gw; m < MTOK; m += NGW) { const float rs = bad ? __builtin_nanf("") : rsqrtf(P.ssq_h2_()[m] * (1.0f / DM) + EPS);
            GAS f32x4* o = (GAS f32x4*)(P.out_() + (size_t)m * DM) + lane_;
#pragma unroll
            for (int j = 0; j < 8; ++j) { const f32x4 g = *((const GAS f32x4*)P.norm_final_() + lane_ + 64 * j); o[64 * j] = o[64 * j] * rs * g; } }
    }
#undef IN
#undef SEAM
}

extern "C" void kernel_launch(void* const* d_in, const int* in_sizes, int n_in, void* d_out, int out_size, void* d_ws, size_t ws_size, hipStream_t stream) {
    static int grid = 0;
    if (grid == 0) {
        if (n_in != 25 || in_sizes[0] != MTOK * DM || out_size != MTOK * DM || ws_size < WS_END) {
            fprintf(stderr, "kernel_launch: unexpected shapes (n_in %d, in0 %d, out %d, ws %zu < %zu)\n", n_in, n_in > 0 ? in_sizes[0] : -1, out_size, ws_size, (size_t)WS_END); grid = -1; return; }
        int dev = 0, cus = 0, per_cu = 0;
        if (hipGetDevice(&dev) != hipSuccess || hipDeviceGetAttribute(&cus, hipDeviceAttributeMultiprocessorCount, dev) != hipSuccess) { grid = -1; return; }
        if (hipFuncSetAttribute((const void*)hybrid_fwd, hipFuncAttributeMaxDynamicSharedMemorySize, LDS_BYTES) != hipSuccess) { fprintf(stderr, "kernel_launch: hipFuncSetAttribute failed\n"); grid = -1; return; }
        if (hipOccupancyMaxActiveBlocksPerMultiprocessor(&per_cu, (const void*)hybrid_fwd, NWAVES * 64, LDS_BYTES) != hipSuccess || per_cu < 1) {
            fprintf(stderr, "kernel_launch: occupancy query reports %d workgroups per CU\n", per_cu); (void)hipGetLastError(); grid = -1; return; }
        grid = cus;
    }
    if (grid < 0) return;
    if (hipMemsetAsync((char*)d_ws + WS_CTL, 0, CTL_ZERO_BYTES, stream) != hipSuccess) { fprintf(stderr, "kernel_launch: memset failed\n"); return; }
    Args a{};
    for (int i = 0; i < 25; ++i) a.in[i] = (const float*)d_in[i];
    a.out = (float*)d_out; a.ws = (unsigned char*)d_ws;
#if MK_SPLIT
    for (int ph = 0; ph < N_PHASES; ++ph) { a.ph_lo = ph; a.ph_hi = ph + 1; hipLaunchKernelGGL(hybrid_fwd, dim3(grid), dim3(NWAVES * 64), LDS_BYTES, stream, a); }
#else
    a.ph_lo = 0; a.ph_hi = N_PHASES;
    hipLaunchKernelGGL(hybrid_fwd, dim3(grid), dim3(NWAVES * 64), LDS_BYTES, stream, a);
#endif
    const hipError_t le = hipPeekAtLastError();
    if (le != hipSuccess) fprintf(stderr, "kernel_launch: launch failed: %s\n", hipGetErrorName(le));
}
```

```cpp
#include <hip/hip_runtime.h>
#include <cstdio>
#include <cstdint>

#define LAS __attribute__((address_space(3)))
#define GAS __attribute__((address_space(1)))
typedef unsigned short bf16;
typedef short bf16x8 __attribute__((ext_vector_type(8)));
typedef short s16x4 __attribute__((ext_vector_type(4)));
typedef float f32x2 __attribute__((ext_vector_type(2)));
typedef float f32x4 __attribute__((ext_vector_type(4)));
typedef float f32x16 __attribute__((ext_vector_type(16)));
typedef unsigned u32x2 __attribute__((ext_vector_type(2)));
typedef unsigned u32x4 __attribute__((ext_vector_type(4)));

#ifndef PROBE_ATT
#define PROBE_ATT 1
#endif
#ifndef PROBE_PH
#define PROBE_PH -1
#endif
#ifndef PROBE_N
#define PROBE_N 0
#endif
#define PROBE_CNT(k) ((PROBE_PH == (k)) ? PROBE_N : 0)
#ifndef MK_SPLIT
#define MK_SPLIT 0
#endif

constexpr int DM = 2048, SEQ = 4096, NBATCH = 2, NMETA = 16, LTOT = SEQ + NMETA, LPAD = 4160;
constexpr int MTOK = NBATCH * SEQ;
constexpr int MROWS = MTOK + 256;
constexpr int NH = 16, DQK = 192, DNOPE = 128, DROPE = 64, DV = 128, QLORA = 512, KVLORA = 512;
constexpr int SSMW = 1024, NG = 64, NS = 64, TC = 16, NCH = SEQ / TC  , KY = 384, KS = 256;
constexpr int DFF = 5632, INW = 6208, NWIN = 6400;
constexpr float EPS = 1e-6f;
constexpr float QSCALE = 0.07216878364870322f * 1.4426950408889634f;
constexpr int NWAVES = 8;
constexpr int N_PHASES = 11;

constexpr size_t MiB = 1u << 20;
constexpr size_t WS_CTL = 0, CTL_ZERO_BYTES = 1 * MiB;
constexpr int CW_TMO = 0, CW_BAR = 4096;
constexpr size_t OFF_SSQ_Q = 64 * 1024, OFF_SSQ_KV = 128 * 1024, OFF_SSQ_H1 = 192 * 1024, OFF_SSQ_H2 = 256 * 1024;
constexpr size_t WS_RS1 = 1 * MiB;
constexpr size_t WS_CS = 1 * MiB + 64 * 1024;
constexpr size_t WS_APOW = 2 * MiB + 256 * 1024;
constexpr size_t WS_BBAR = 3 * MiB;
constexpr size_t WS_X0 = 3 * MiB + 512 * 1024;
constexpr size_t WS_UMETA = 3 * MiB + 576 * 1024;
constexpr size_t WS_WIN = 4 * MiB;
constexpr size_t WS_SLOC = 4 * MiB;
constexpr size_t WS_P = 4 * MiB;
constexpr size_t WS_H1B = 4 * MiB;
constexpr size_t WS_WQ = 29 * MiB;
constexpr size_t WS_WKV = 32 * MiB;
constexpr size_t WS_BTS = 36 * MiB;
constexpr size_t WS_BTY = 41 * MiB;
constexpr size_t WS_WGLU = 53 * MiB;
constexpr size_t WS_WAP = 61 * MiB;
constexpr size_t WS_F = 36 * MiB;
constexpr size_t WS_XB = 69 * MiB;
constexpr size_t WS_O = 69 * MiB;
constexpr size_t WS_UA = 102 * MiB;
constexpr size_t WS_MIXED = 102 * MiB;
constexpr size_t WS_QLAT = 126 * MiB;
constexpr size_t WS_Y = 126 * MiB;
constexpr size_t WS_KVLAT = 134 * MiB;
constexpr size_t WS_KR = 143 * MiB;
constexpr size_t WS_Q = 145 * MiB;
constexpr size_t WS_KN = 193 * MiB;
constexpr size_t WS_V = 226 * MiB;
constexpr size_t WS_WOUT = 170 * MiB;
constexpr size_t WS_WFFN = 178 * MiB;
constexpr size_t WS_WDOWN = 222 * MiB;
constexpr size_t WS_END = 259 * MiB;
static_assert(WS_WDOWN + (size_t)2048 * 5632 * 2 <= 244 * MiB && WS_V + (size_t)2 * 16 * 4160 * 128 * 2 <= WS_END, "ws map");
static_assert(WS_F + (size_t)8192 * 5632 * 2 <= WS_QLAT && WS_UA + (size_t)NG * 512 * KY * 2 <= WS_QLAT, "ws map 2");

constexpr int RING_BYTES = 131072;
constexpr int LDSCTL_OFF = RING_BYTES, MISC_OFF = LDSCTL_OFF + 320;
constexpr int LDS_BYTES = 147456;

#define RLX_AGENT __ATOMIC_RELAXED, __HIP_MEMORY_SCOPE_AGENT
#define LDS_WAIT() asm volatile("s_waitcnt lgkmcnt(0)" ::: "memory")
#define VM_WAIT() asm volatile("s_waitcnt vmcnt(0)" ::: "memory")
#define SBAR() __builtin_amdgcn_sched_barrier(0)
__device__ __forceinline__ unsigned cvt_pk_bf16(float lo, float hi) { unsigned r; asm volatile("v_cvt_pk_bf16_f32 %0, %1, %2" : "=v"(r) : "v"(lo), "v"(hi)); return r; }
__device__ __forceinline__ float bf_lo(unsigned w) { return __uint_as_float(w << 16); }
__device__ __forceinline__ float bf_hi(unsigned w) { return __uint_as_float(w & 0xffff0000u); }
__device__ __forceinline__ float fast_sigmoid(float x) { return __builtin_amdgcn_rcpf(1.0f + __builtin_amdgcn_exp2f(-1.4426950408889634f * x)); }
__device__ __forceinline__ float gelu_tanh(float x) { const float z = 0.7978845608028654f * (x + 0.044715f * x * x * x); return x * fast_sigmoid(2.0f * z); }
__device__ __forceinline__ u32x4 pack8(const f32x4 a, const f32x4 b) { u32x4 w; w.x = cvt_pk_bf16(a[0], a[1]); w.y = cvt_pk_bf16(a[2], a[3]); w.z = cvt_pk_bf16(b[0], b[1]); w.w = cvt_pk_bf16(b[2], b[3]); return w; }
__device__ __forceinline__ void unpack8(const u32x4 w, f32x4& a, f32x4& b) { a = (f32x4){bf_lo(w.x), bf_hi(w.x), bf_lo(w.y), bf_hi(w.y)}; b = (f32x4){bf_lo(w.z), bf_hi(w.z), bf_lo(w.w), bf_hi(w.w)}; }

struct Args { const float* in[25]; float* out; unsigned char* ws; int ph_lo, ph_hi; };
struct PtrsT {
    const Args& a;
    __device__ __forceinline__ explicit PtrsT(const Args& a_) : a(a_) {}
#define PIN(name, idx) __device__ __forceinline__ const float* name##_() const { return a.in[idx]; }
    PIN(x, 0) PIN(meta, 1) PIN(norm_mix, 2) PIN(w_in, 3) PIN(norm_q, 4) PIN(w_q_up, 5) PIN(norm_kv, 6) PIN(w_kv_up, 7) PIN(w_attn_proj, 8) PIN(lam_re, 9) PIN(lam_im, 10) PIN(log_step, 11)
    PIN(b_re, 12) PIN(b_im, 13) PIN(c_re, 14) PIN(c_im, 15) PIN(ssm_d, 16) PIN(w_glu_val, 17) PIN(w_glu_gate, 18) PIN(w_out, 19) PIN(norm_ffn, 20) PIN(w_ffn_gate, 21) PIN(w_ffn_up, 22)
    PIN(w_ffn_down, 23) PIN(norm_final, 24)
#undef PIN
#define PWS(type, name, off) __device__ __forceinline__ type* name##_() const { return (type*)(a.ws + (off)); }
    PWS(unsigned, ctl, WS_CTL) PWS(float, ssq_q, OFF_SSQ_Q) PWS(float, ssq_kv, OFF_SSQ_KV) PWS(float, ssq_h1, OFF_SSQ_H1) PWS(float, ssq_h2, OFF_SSQ_H2) PWS(float, rs1, WS_RS1) PWS(float, umeta, WS_UMETA)
    PWS(float, sloc, WS_SLOC) PWS(f32x2, cs, WS_CS) PWS(f32x2, apow, WS_APOW) PWS(f32x2, bbar, WS_BBAR) PWS(f32x2, x0, WS_X0)
    PWS(bf16, win, WS_WIN) PWS(bf16, wq, WS_WQ) PWS(bf16, wkv, WS_WKV) PWS(bf16, bts, WS_BTS) PWS(bf16, bty, WS_BTY) PWS(bf16, wglu, WS_WGLU) PWS(bf16, wap, WS_WAP) PWS(bf16, wout, WS_WOUT)
    PWS(bf16, wffn, WS_WFFN) PWS(bf16, wdown, WS_WDOWN) PWS(bf16, xb, WS_XB) PWS(bf16, qlat, WS_QLAT) PWS(bf16, kvlat, WS_KVLAT) PWS(bf16, ua, WS_UA) PWS(bf16, kr, WS_KR) PWS(bf16, q, WS_Q)
    PWS(bf16, kn, WS_KN) PWS(bf16, v, WS_V) PWS(bf16, o, WS_O) PWS(bf16, y, WS_Y) PWS(bf16, pbuf, WS_P) PWS(bf16, mixed, WS_MIXED) PWS(bf16, h1b, WS_H1B) PWS(bf16, f, WS_F)
#undef PWS
    __device__ __forceinline__ float* out_() const { return a.out; }
    __device__ __forceinline__ bf16* sg_() const { return (bf16*)a.out; }
};
typedef PtrsT Ptrs;

namespace pg8 {
constexpr int BM = 256, BK = 64, HALF = 128, HTB = HALF * BK * 2, STAGE_BYTES = 8 * HTB, NXCD = 8, WGM = 8;
__host__ __device__ __forceinline__ int lds_byte(int r, int c) { const int st = (r >> 4) * 2 + (c >> 5), rr = r & 15, cc = c & 31, ob = rr * 64 + cc * 2; return st * 1024 + (ob ^ (((ob >> 9) & 1) << 5)); }
__host__ __device__ __forceinline__ void stage_rc(int b, int& R, int& C) { const int st = b / 1024, sb = b % 1024, swz = sb ^ (((sb >> 9) & 1) << 5); R = (st >> 1) * 16 + swz / 64; C = (st & 1) * 32 + (swz % 64) / 2; }
__host__ __device__ __forceinline__ int perm32(int rho) { const int n = rho >> 4, i = rho & 15; return 8 * (i >> 2) + 4 * n + (i & 3); }

struct Unit { const char* A; const char* B; unsigned lda, ldb; int nt, pm, pn, kind, aux; };

__device__ __forceinline__ void tile_order(int L, int nM, int nN, int& pm, int& pn) {
    const int nwg = nM * nN; int wgid = L;
    { const int q = nwg / NXCD, r = nwg % NXCD, xcd = wgid % NXCD, off = wgid / NXCD; wgid = (xcd < r ? xcd * (q + 1) : r * (q + 1) + (xcd - r) * q) + off; }
    const int nig = WGM * nN, gid = wgid / nig, fm = gid * WGM, gsz = (nM - fm) < WGM ? (nM - fm) : WGM;
    pm = fm + ((wgid % nig) % gsz); pn = (wgid % nig) / gsz;
}

template <class Sched, class Epi>
__device__ __forceinline__ void gemm_run(LAS unsigned char* lds, const Sched& S, const Epi& E) {
    const int tid = threadIdx.x, wid = __builtin_amdgcn_readfirstlane(tid >> 6), lane = tid & 63, wr = wid >> 2, wc = wid & 3, fr = lane & 15, fq = lane >> 4;
    unsigned RA[2], RB[2], C2[2];
#pragma unroll
    for (int i = 0; i < 2; ++i) { int R, C; stage_rc(tid * 16 + i * 8192, R, C); RA[i] = (unsigned)R; RB[i] = (unsigned)((R & ~31) + perm32(R & 31)); C2[i] = (unsigned)(C * 2); }
    const unsigned ldsw = (unsigned)wid * 1024u;
    const int aoff = lds_byte(wr * 64 + fr, fq * 8), boff = lds_byte(wc * 32 + fr, fq * 8);
#define PG8_SA(b, h) (((b) * 2 + (h)) * HTB)
#define PG8_SB(b, h) ((4 + (b) * 2 + (h)) * HTB)
#define PG8_STAGE(bufoff, gbase, RR, ld) do { _Pragma("unroll") for (int _i = 0; _i < 2; ++_i) \
        __builtin_amdgcn_global_load_lds((const unsigned*)((const char*)(gbase) + (RR)[_i] * (ld) + C2[_i]), (LAS unsigned*)(lds + (bufoff) + ldsw + _i * 8192), 16, 0, 0); } while (0)
#define PG8_LDA(dst, b, h) do { _Pragma("unroll") for (int m = 0; m < 4; ++m) _Pragma("unroll") for (int k = 0; k < 2; ++k) dst[m][k] = *(const LAS bf16x8*)(lds + PG8_SA(b, h) + aoff + m * 2048 + k * 1024); } while (0)
#define PG8_LDB(dst, b, h) do { _Pragma("unroll") for (int n = 0; n < 2; ++n) _Pragma("unroll") for (int k = 0; k < 2; ++k) dst[n][k] = *(const LAS bf16x8*)(lds + PG8_SB(b, h) + boff + n * 2048 + k * 1024); } while (0)
#define PG8_MMA(ai, bj, At, Bt) do { __builtin_amdgcn_s_setprio(1); _Pragma("unroll") for (int m = 0; m < 4; ++m) _Pragma("unroll") for (int n = 0; n < 2; ++n) _Pragma("unroll") for (int k = 0; k < 2; ++k) \
        acc[ai][bj][m][n] = __builtin_amdgcn_mfma_f32_16x16x32_bf16(Bt[n][k], At[m][k], acc[ai][bj][m][n], 0, 0, 0); __builtin_amdgcn_s_setprio(0); } while (0)
#define PG8_WAIT_V(n) asm volatile("s_waitcnt vmcnt(" #n ")" ::: "memory")
#define PG8_WAIT_L(n) asm volatile("s_waitcnt lgkmcnt(" #n ")" ::: "memory")
#define PG8_BAR __builtin_amdgcn_s_barrier()
#define PG8_SCHED __builtin_amdgcn_sched_barrier(0)
    Unit cur, nxt; int ui = 0;
    if (!S.next(0, cur)) return;
    f32x4 acc[2][2][4][2];
#pragma unroll
    for (int a = 0; a < 2; ++a)
#pragma unroll
        for (int b = 0; b < 2; ++b)
#pragma unroll
            for (int m = 0; m < 4; ++m)
#pragma unroll
                for (int n = 0; n < 2; ++n) acc[a][b][m][n] = (f32x4){0.f, 0.f, 0.f, 0.f};
    bf16x8 At[4][2], B0[2][2], B1[2][2];
    const char* cA = cur.A; const char* cB = cur.B; unsigned lda = cur.lda, ldb = cur.ldb;
    constexpr unsigned kstep = BK * 2;
    PG8_STAGE(PG8_SB(0, 0), cB, RB, ldb); PG8_STAGE(PG8_SB(0, 1), cB + (size_t)HALF * ldb, RB, ldb); PG8_STAGE(PG8_SA(0, 0), cA, RA, lda); PG8_STAGE(PG8_SA(0, 1), cA + (size_t)HALF * lda, RA, lda);
    if (wr == 1) PG8_BAR;
    PG8_WAIT_V(2); PG8_BAR;
    PG8_STAGE(PG8_SB(1, 0), cB + kstep, RB, ldb); PG8_STAGE(PG8_SA(1, 0), cA + kstep, RA, lda); PG8_STAGE(PG8_SB(1, 1), cB + (size_t)HALF * ldb + kstep, RB, ldb);
    PG8_WAIT_V(6); PG8_BAR;
    for (;;) {
        const bool has_next = S.next(ui + 1, nxt);
        const char* nA = has_next ? nxt.A : cA; const char* nB = has_next ? nxt.B : cB; const unsigned nlda = has_next ? nxt.lda : lda, nldb = has_next ? nxt.ldb : ldb;
        const int nt = cur.nt;
        for (int t = 0; t < nt; t += 2) {
            const bool last = (t == nt - 2);
            const char* a1 = cA + (size_t)(t + 1) * kstep;
            const char* a2 = last ? nA : cA + (size_t)(t + 2) * kstep; const char* b2 = last ? nB : cB + (size_t)(t + 2) * kstep;
            const unsigned la2 = last ? nlda : lda, lb2 = last ? nldb : ldb;
            const char* a3 = a2 + kstep; const char* b3 = b2 + kstep;
            PG8_LDB(B0, 0, 0); PG8_LDB(B1, 0, 1); PG8_SCHED; PG8_LDA(At, 0, 0); PG8_STAGE(PG8_SA(1, 1), a1 + (size_t)HALF * lda, RA, lda);
            PG8_WAIT_V(8); PG8_WAIT_L(0); PG8_BAR; PG8_MMA(0, 0, At, B0); PG8_MMA(0, 1, At, B1); PG8_BAR; PG8_SCHED;
            PG8_LDA(At, 0, 1); PG8_STAGE(PG8_SB(0, 0), b2, RB, lb2); PG8_STAGE(PG8_SB(0, 1), b2 + (size_t)HALF * lb2, RB, lb2); PG8_STAGE(PG8_SA(0, 0), a2, RA, la2);
            PG8_WAIT_V(8); PG8_WAIT_L(0); PG8_BAR; PG8_MMA(1, 0, At, B0); PG8_MMA(1, 1, At, B1); PG8_BAR; PG8_SCHED;
            PG8_LDB(B0, 1, 0); PG8_LDB(B1, 1, 1); PG8_SCHED; PG8_LDA(At, 1, 0); PG8_STAGE(PG8_SA(0, 1), a2 + (size_t)HALF * la2, RA, la2);
            PG8_WAIT_V(8); PG8_WAIT_L(0); PG8_BAR; PG8_MMA(0, 0, At, B0); PG8_MMA(0, 1, At, B1); PG8_BAR; PG8_SCHED;
            PG8_LDA(At, 1, 1); PG8_STAGE(PG8_SB(1, 0), b3, RB, lb2); PG8_STAGE(PG8_SB(1, 1), b3 + (size_t)HALF * lb2, RB, lb2); PG8_STAGE(PG8_SA(1, 0), a3, RA, la2);
            PG8_WAIT_V(8); PG8_WAIT_L(0); PG8_BAR; PG8_MMA(1, 0, At, B0); PG8_MMA(1, 1, At, B1); PG8_BAR; PG8_SCHED;
        }
        if (wr == 0) PG8_BAR;
        E(acc, cur, wr, wc, fr, fq);
        if (!has_next) break;
#pragma unroll
        for (int a = 0; a < 2; ++a)
#pragma unroll
            for (int b = 0; b < 2; ++b)
#pragma unroll
                for (int m = 0; m < 4; ++m)
#pragma unroll
                    for (int n = 0; n < 2; ++n) acc[a][b][m][n] = (f32x4){0.f, 0.f, 0.f, 0.f};
        cur = nxt; cA = nA; cB = nB; lda = nlda; ldb = nldb; ++ui;
        if (wr == 1) PG8_BAR;
    }
    PG8_WAIT_V(0);
    PG8_BAR;
#undef PG8_SA
#undef PG8_SB
#undef PG8_STAGE
#undef PG8_LDA
#undef PG8_LDB
#undef PG8_MMA
#undef PG8_WAIT_V
#undef PG8_WAIT_L
#undef PG8_BAR
#undef PG8_SCHED
}
}
using pg8::Unit;

enum { K_QLAT = 0, K_KVLAT, K_U, K_GATES, K_KR, K_QN, K_QR, K_KV, K_SLOC, K_Y, K_GLU, K_AP, K_OUT, K_FFN, K_DOWN };

template <int PH> struct Epi {
    const Ptrs& P; bool dry;
    __device__ __forceinline__ explicit Epi(const Ptrs& p, bool d = false) : P(p), dry(d) {}
    __device__ __forceinline__ void operator()(f32x4 (&acc)[2][2][4][2], const Unit& u, int wr, int wc, int fr, int fq) const {
        const int kind = u.kind;
        if (dry) {
#pragma unroll
            for (int a = 0; a < 2; ++a)
#pragma unroll
                for (int b = 0; b < 2; ++b)
#pragma unroll
                    for (int m = 0; m < 4; ++m)
#pragma unroll
                        for (int n = 0; n < 2; ++n) asm volatile("" :: "v"(acc[a][b][m][n]));
            return; }
#pragma unroll
        for (int ai = 0; ai < 2; ++ai)
#pragma unroll
            for (int m = 0; m < 4; ++m) {
                const int rt = ai * 128 + wr * 64 + m * 16 + fr;
                const int row = u.pm * 256 + rt;
                const int c8 = wc * 32 + fq * 8;
                if constexpr (PH == 1) {
                    const float rs = P.rs1_()[row];
                    if (kind == K_QLAT || kind == K_KVLAT) {
                        bf16* dst = (kind == K_QLAT ? P.qlat_() : P.kvlat_()) + (size_t)row * 512 + (u.pn & 1) * 256 + c8;
                        float ss = 0.f;
#pragma unroll
                        for (int bj = 0; bj < 2; ++bj) { const f32x4 v0 = acc[ai][bj][m][0] * rs, v1 = acc[ai][bj][m][1] * rs;
                            ss += (v0[0] * v0[0] + v0[1] * v0[1]) + (v0[2] * v0[2] + v0[3] * v0[3]) + (v1[0] * v1[0] + v1[1] * v1[1]) + (v1[2] * v1[2] + v1[3] * v1[3]);
                            *(u32x4*)(dst + bj * 128) = pack8(v0, v1); }
                        ss += __shfl_xor(ss, 16); ss += __shfl_xor(ss, 32);
                        if (fq == 0) atomicAdd((kind == K_QLAT ? P.ssq_q_() : P.ssq_kv_()) + row, ss);
                    } else if (kind == K_U) {
#pragma unroll
                        for (int bj = 0; bj < 2; ++bj) { const f32x4 v0 = acc[ai][bj][m][0] * rs, v1 = acc[ai][bj][m][1] * rs;
                            const int chan = (u.pn - 4) * 256 + bj * 128 + c8;
                            if (u.pm < 32) { const int b = row >> 12, i = row & 4095, c = i >> 4, s = i & 15, g = chan >> 4, p0 = chan & 15;
                                *(u32x4*)(P.ua_() + ((size_t)(g * 512 + b * 256 + c) * KY + s * 16 + p0)) = pack8(v0, v1); }
                            else if (rt < NMETA) { *(f32x4*)(P.umeta_() + rt * 1024 + chan) = v0; *(f32x4*)(P.umeta_() + rt * 1024 + chan + 4) = v1; } }
                    } else if (kind == K_GATES) {
#pragma unroll
                        for (int bj = 0; bj < 2; ++bj) { f32x4 v0 = acc[ai][bj][m][0] * rs, v1 = acc[ai][bj][m][1] * rs;
#pragma unroll
                            for (int j = 0; j < 4; ++j) { v0[j] = fast_sigmoid(v0[j]); v1[j] = fast_sigmoid(v1[j]); }
                            *(u32x4*)(P.sg_() + (size_t)row * 4096 + (u.pn - 8) * 256 + bj * 128 + c8) = pack8(v0, v1); }
                    } else {
                        if (wc < 2) { const int jp = wc * 4 + fq; const bool real = u.pm < 32; const int pos = real ? NMETA + (row & 4095) : rt;
                            if (real || rt < NMETA) {
                                const f32x4 x1 = acc[ai][0][m][0] * rs, x2 = acc[ai][0][m][1] * rs;
                                const f32x4 cs0 = *(const f32x4*)(P.cs_() + (size_t)pos * 32 + jp * 4), cs1 = *(const f32x4*)(P.cs_() + (size_t)pos * 32 + jp * 4 + 2);
                                const f32x4 cc = {cs0[0], cs0[2], cs1[0], cs1[2]}, sn = {cs0[1], cs0[3], cs1[1], cs1[3]};
                                const f32x4 o1 = x1 * cc - x2 * sn, o2 = x2 * cc + x1 * sn;
                                u32x2 w1, w2; w1.x = cvt_pk_bf16(o1[0], o1[1]); w1.y = cvt_pk_bf16(o1[2], o1[3]); w2.x = cvt_pk_bf16(o2[0], o2[1]); w2.y = cvt_pk_bf16(o2[2], o2[3]);
                                if (real) { bf16* d = P.kr_() + ((size_t)(row >> 12) * LPAD + pos) * 64 + jp * 4; *(u32x2*)d = w1; *(u32x2*)(d + 32) = w2; }
                                else { bf16* d = P.kr_() + (size_t)pos * 64 + jp * 4; *(u32x2*)d = w1; *(u32x2*)(d + 32) = w2; d += (size_t)LPAD * 64; *(u32x2*)d = w1; *(u32x2*)(d + 32) = w2; } } }
                    }
                } else if constexpr (PH == 2) {
                    if (kind == K_QN) {
                        const float sc = rsqrtf(P.ssq_q_()[row] * (1.0f / 512.0f) + EPS) * QSCALE; const int b = row >> 12, i = row & 4095;
#pragma unroll
                        for (int bj = 0; bj < 2; ++bj) { const int h = u.pn * 2 + bj;
                            *(u32x4*)(P.q_() + ((size_t)(b * NH + h) * SEQ + i) * DQK + c8) = pack8(acc[ai][bj][m][0] * sc, acc[ai][bj][m][1] * sc); }
                    } else if (kind == K_QR) {
                        const float sc = rsqrtf(P.ssq_q_()[row] * (1.0f / 512.0f) + EPS) * QSCALE; const int b = row >> 12, i = row & 4095, pos = NMETA + i;
                        const int jp = (wc & 1) * 4 + fq;
                        const f32x4 cs0 = *(const f32x4*)(P.cs_() + (size_t)pos * 32 + jp * 4), cs1 = *(const f32x4*)(P.cs_() + (size_t)pos * 32 + jp * 4 + 2);
                        const f32x4 cc = {cs0[0], cs0[2], cs1[0], cs1[2]}, sn = {cs0[1], cs0[3], cs1[1], cs1[3]};
#pragma unroll
                        for (int bj = 0; bj < 2; ++bj) { const int h = (u.pn - 8) * 4 + bj * 2 + (wc >> 1);
                            const f32x4 x1 = acc[ai][bj][m][0] * sc, x2 = acc[ai][bj][m][1] * sc; const f32x4 o1 = x1 * cc - x2 * sn, o2 = x2 * cc + x1 * sn;
                            u32x2 w1, w2; w1.x = cvt_pk_bf16(o1[0], o1[1]); w1.y = cvt_pk_bf16(o1[2], o1[3]); w2.x = cvt_pk_bf16(o2[0], o2[1]); w2.y = cvt_pk_bf16(o2[2], o2[3]);
                            bf16* d = P.q_() + ((size_t)(b * NH + h) * SEQ + i) * DQK + DNOPE + jp * 4; *(u32x2*)d = w1; *(u32x2*)(d + 32) = w2; }
                    } else if (kind == K_KV) {
                        const float sc = rsqrtf(P.ssq_kv_()[row] * (1.0f / 512.0f) + EPS); const int h = u.pn; const bool real = u.pm < 32;
                        if (real || rt < NMETA) { const int b = real ? (row >> 12) : 0, pos = real ? NMETA + (row & 4095) : rt;
#pragma unroll
                            for (int bj = 0; bj < 2; ++bj) { const u32x4 w = pack8(acc[ai][bj][m][0] * sc, acc[ai][bj][m][1] * sc);
                                bf16* d = (bj == 0 ? P.kn_() : P.v_()) + ((size_t)(b * NH + h) * LPAD + pos) * 128 + c8; *(u32x4*)d = w;
                                if (!real) *(u32x4*)(d + (size_t)NH * LPAD * 128) = w; } }
                    } else {
                        float* d = P.sloc_() + ((size_t)(u.aux * 512 + row) * 128 + c8);
                        *(f32x4*)d = acc[ai][0][m][0]; *(f32x4*)(d + 4) = acc[ai][0][m][1];
                    }
                } else if constexpr (PH == 4) {
#pragma unroll
                    for (int bj = 0; bj < 2; ++bj) { f32x4 v0 = acc[ai][bj][m][0], v1 = acc[ai][bj][m][1];
#pragma unroll
                        for (int j = 0; j < 4; ++j) { v0[j] = gelu_tanh(v0[j]); v1[j] = gelu_tanh(v1[j]); }
                        const int t = bj * 8 + wc * 2 + (fq >> 1), p0 = (fq & 1) * 8; const int tok = u.pm * SEQ + rt * TC + t;
                        *(u32x4*)(P.y_() + (size_t)tok * SSMW + u.aux * 16 + p0) = pack8(v0, v1); }
                } else if constexpr (PH == 5) {
                    const int col = u.pn * 128 + c8;
                    f32x4 g0, g1; unpack8(*(const u32x4*)(P.sg_() + (size_t)row * 4096 + 2048 + col), g0, g1);
                    f32x4 v0 = acc[ai][0][m][0], v1 = acc[ai][0][m][1]; const f32x4 t0 = acc[ai][1][m][0], t1 = acc[ai][1][m][1];
#pragma unroll
                    for (int j = 0; j < 4; ++j) { v0[j] = v0[j] * fast_sigmoid(t0[j]) * g0[j]; v1[j] = v1[j] * fast_sigmoid(t1[j]) * g1[j]; }
                    *(u32x4*)(P.pbuf_() + (size_t)row * DM + col) = pack8(v0, v1);
                } else if constexpr (PH == 6) {
#pragma unroll
                    for (int bj = 0; bj < 2; ++bj) { const int col = u.pn * 256 + bj * 128 + c8;
                        f32x4 g0, g1, p0, p1; unpack8(*(const u32x4*)(P.sg_() + (size_t)row * 4096 + col), g0, g1); unpack8(*(const u32x4*)(P.pbuf_() + (size_t)row * DM + col), p0, p1);
                        *(u32x4*)(P.mixed_() + (size_t)row * DM + col) = pack8(acc[ai][bj][m][0] * g0 + p0, acc[ai][bj][m][1] * g1 + p1); }
                } else if constexpr (PH == 7) {
                    float ss = 0.f;
#pragma unroll
                    for (int bj = 0; bj < 2; ++bj) { const int col = u.pn * 256 + bj * 128 + c8; const size_t off = (size_t)row * DM + col;
                        const f32x4 v0 = acc[ai][bj][m][0] + *(const f32x4*)(P.x_() + off), v1 = acc[ai][bj][m][1] + *(const f32x4*)(P.x_() + off + 4);
                        ss += (v0[0] * v0[0] + v0[1] * v0[1]) + (v0[2] * v0[2] + v0[3] * v0[3]) + (v1[0] * v1[0] + v1[1] * v1[1]) + (v1[2] * v1[2] + v1[3] * v1[3]);
                        *(f32x4*)(P.out_() + off) = v0; *(f32x4*)(P.out_() + off + 4) = v1; *(u32x4*)(P.h1b_() + off) = pack8(v0, v1); }
                    ss += __shfl_xor(ss, 16); ss += __shfl_xor(ss, 32);
                    if (fq == 0) atomicAdd(P.ssq_h1_() + row, ss);
                } else if constexpr (PH == 8) {
                    const float rs = rsqrtf(P.ssq_h1_()[row] * (1.0f / 2048.0f) + EPS);
                    f32x4 g0 = acc[ai][0][m][0] * rs, g1 = acc[ai][0][m][1] * rs; const f32x4 u0 = acc[ai][1][m][0] * rs, u1 = acc[ai][1][m][1] * rs;
#pragma unroll
                    for (int j = 0; j < 4; ++j) { g0[j] = g0[j] * fast_sigmoid(g0[j]) * u0[j]; g1[j] = g1[j] * fast_sigmoid(g1[j]) * u1[j]; }
                    *(u32x4*)(P.f_() + (size_t)row * DFF + u.pn * 128 + c8) = pack8(g0, g1);
                } else if constexpr (PH == 9) {
                    float ss = 0.f;
#pragma unroll
                    for (int bj = 0; bj < 2; ++bj) { const size_t off = (size_t)row * DM + u.pn * 256 + bj * 128 + c8;
                        const f32x4 v0 = acc[ai][bj][m][0] + *(const f32x4*)(P.out_() + off), v1 = acc[ai][bj][m][1] + *(const f32x4*)(P.out_() + off + 4);
                        ss += (v0[0] * v0[0] + v0[1] * v0[1]) + (v0[2] * v0[2] + v0[3] * v0[3]) + (v1[0] * v1[0] + v1[1] * v1[1]) + (v1[2] * v1[2] + v1[3] * v1[3]);
                        *(f32x4*)(P.out_() + off) = v0; *(f32x4*)(P.out_() + off + 4) = v1; }
                    ss += __shfl_xor(ss, 16); ss += __shfl_xor(ss, 32);
                    if (fq == 0) atomicAdd(P.ssq_h2_() + row, ss);
                }
            }
    }
};

template <int PH> struct Sched {
    const Ptrs& P; int G, c;
    __device__ __forceinline__ Sched(const Ptrs& p, int g, int c_) : P(p), G(g), c(c_) {}
    __device__ __forceinline__ bool next(int i, Unit& u) const {
        int L = i * G + c; u.aux = 0;
        if constexpr (PH == 1) {
            if (L < 800) { pg8::tile_order(L, 32, 25, u.pm, u.pn); }
            else { L -= 800; if (L >= 7) return false; u.pm = 32; u.pn = (L < 6) ? L + 2 : 24; }
            u.A = (const char*)P.xb_() + (size_t)u.pm * 256 * 4096; u.B = (const char*)P.win_() + (size_t)u.pn * 256 * 4096; u.lda = 4096; u.ldb = 4096; u.nt = 32;
            u.kind = u.pn < 2 ? K_QLAT : u.pn < 4 ? K_KVLAT : u.pn < 8 ? K_U : u.pn < 24 ? K_GATES : K_KR; return true;
        } else if constexpr (PH == 2) {
            if (L < 128) { const int g = L >> 1; u.pm = L & 1; u.pn = 0; u.aux = g; u.kind = K_SLOC; u.A = (const char*)P.ua_() + (size_t)(g * 512 + u.pm * 256) * (KY * 2); u.B = (const char*)P.bts_() + (size_t)g * 128 * (KS * 2);
                u.lda = KY * 2; u.ldb = KS * 2; u.nt = KS / 64; return true; }
            L -= 128;
            if (L < 528) { pg8::tile_order(L, 33, 16, u.pm, u.pn); u.kind = K_KV; u.A = (const char*)P.kvlat_() + (size_t)u.pm * 256 * 1024; u.B = (const char*)P.wkv_() + (size_t)u.pn * 256 * 1024; u.lda = 1024; u.ldb = 1024; u.nt = 8; return true; }
            L -= 528;
            if (L < 384) { pg8::tile_order(L, 32, 12, u.pm, u.pn); u.kind = u.pn < 8 ? K_QN : K_QR; u.A = (const char*)P.qlat_() + (size_t)u.pm * 256 * 1024; u.B = (const char*)P.wq_() + (size_t)u.pn * 256 * 1024; u.lda = 1024; u.ldb = 1024; u.nt = 8; return true; }
            return false;
        } else if constexpr (PH == 4) {
            if (L >= 128) return false; const int g = L >> 1; u.pm = L & 1; u.pn = 0; u.aux = g; u.kind = K_Y;
            u.A = (const char*)P.ua_() + (size_t)(g * 512 + u.pm * 256) * (KY * 2); u.B = (const char*)P.bty_() + (size_t)g * 256 * (KY * 2); u.lda = KY * 2; u.ldb = KY * 2; u.nt = KY / 64; return true;
        } else if constexpr (PH == 5) {
            if (L >= 32 * 16) return false; pg8::tile_order(L, 32, 16, u.pm, u.pn); u.kind = K_GLU;
            u.A = (const char*)P.y_() + (size_t)u.pm * 256 * 2048; u.B = (const char*)P.wglu_() + (size_t)u.pn * 256 * 2048; u.lda = 2048; u.ldb = 2048; u.nt = 16; return true;
        } else if constexpr (PH == 6 || PH == 7) {
            if (L >= 32 * 8) return false; pg8::tile_order(L, 32, 8, u.pm, u.pn); u.kind = PH == 6 ? K_AP : K_OUT;
            u.A = (const char*)(PH == 6 ? P.o_() : P.mixed_()) + (size_t)u.pm * 256 * 4096; u.B = (const char*)(PH == 6 ? P.wap_() : P.wout_()) + (size_t)u.pn * 256 * 4096; u.lda = 4096; u.ldb = 4096; u.nt = 32; return true;
        } else if constexpr (PH == 8) {
            if (L >= 32 * 44) return false; pg8::tile_order(L, 32, 44, u.pm, u.pn); u.kind = K_FFN;
            u.A = (const char*)P.h1b_() + (size_t)u.pm * 256 * 4096; u.B = (const char*)P.wffn_() + (size_t)u.pn * 256 * 4096; u.lda = 4096; u.ldb = 4096; u.nt = 32; return true;
        } else {
            if (L >= 32 * 8) return false; pg8::tile_order(L, 32, 8, u.pm, u.pn); u.kind = K_DOWN;
            u.A = (const char*)P.f_() + (size_t)u.pm * 256 * (DFF * 2); u.B = (const char*)P.wdown_() + (size_t)u.pn * 256 * (DFF * 2); u.lda = DFF * 2; u.ldb = DFF * 2; u.nt = DFF / 64; return true;
        }
    }
};

namespace att {
constexpr int QBLK = 32, KVBLK = 64, QB = 256;
constexpr int SHM_V = 16384, SHM_K = 16384, SHM_R = 8192;
constexpr int OFF_V = 0, OFF_K = 2 * SHM_V, OFF_R = OFF_K + 2 * SHM_K, OFF_WS = OFF_R + 2 * SHM_R;
constexpr float THRL = 8.f;
#define KSWZ(row, colB) ((row) * 256 + ((colB) ^ (((row) & 7) << 4)))
#define RSWZ(row, chunk) ((row) * 128 + ((((chunk) ^ (row)) & 7) << 4))
__device__ __forceinline__ int v_st(int k, int c) { const int kk = (k & ~0xC) | ((k & 4) << 1) | ((k & 8) >> 1); return ((kk >> 3) * 4 + (c >> 5)) * 512 + ((kk & 7) * 32 + (c & 31)) * 2; }
__device__ __forceinline__ int v_rd_base(int lane) { return ((lane & 3) << 3) | (((lane >> 2) & 3) << 6) | (((lane >> 4) & 1) << 5) | (((lane >> 5) & 1) << 8); }
constexpr int v_rd_off(int d0, int ks, int half) { return d0 * 512 + ks * 4096 + half * 2048; }
__device__ __forceinline__ int crow(int r, int hi) { return (r & 3) + 8 * (r >> 2) + 4 * hi; }

template <int KB>
__device__ __forceinline__ void qkt(f32x16& p0, f32x16& p1, LAS const char* lds, int r32, int hi, const bf16x8* qr) {
    p0 = f32x16{}; p1 = f32x16{};
    LAS const char* kb[4];
#pragma unroll
    for (int dd = 0; dd < 4; ++dd) kb[dd] = lds + OFF_K + KB * SHM_K + KSWZ(r32, (dd * 16 + hi * 8) * 2);
#pragma unroll
    for (int d0 = 0; d0 < 8; ++d0) { LAS const char* a = kb[d0 & 3] + (d0 >> 2) * 128;
        const bf16x8 b0 = *(LAS const bf16x8*)(a); const bf16x8 b1 = *(LAS const bf16x8*)(a + 32 * 256);
        p0 = __builtin_amdgcn_mfma_f32_32x32x16_bf16(b0, qr[d0], p0, 0, 0, 0);
        p1 = __builtin_amdgcn_mfma_f32_32x32x16_bf16(b1, qr[d0], p1, 0, 0, 0); }
#pragma unroll
    for (int d0 = 0; d0 < 4; ++d0) { LAS const char* a = lds + OFF_R + KB * SHM_R + RSWZ(r32, d0 * 2 + hi);
        const bf16x8 b0 = *(LAS const bf16x8*)(a); const bf16x8 b1 = *(LAS const bf16x8*)(a + 32 * 128);
        p0 = __builtin_amdgcn_mfma_f32_32x32x16_bf16(b0, qr[8 + d0], p0, 0, 0, 0);
        p1 = __builtin_amdgcn_mfma_f32_32x32x16_bf16(b1, qr[8 + d0], p1, 0, 0, 0); }
}
template <int VB>
__device__ __forceinline__ void pv_tile(f32x16* o, int vb0, bf16x8 pa0, bf16x8 pa1, bf16x8 pa2, bf16x8 pa3) {
#define TRRD(dst, off) asm volatile("ds_read_b64_tr_b16 %0, %1 offset:%2" : "=&v"(dst) : "v"(vb0), "i"(off) : "memory")
#define PV_D0(d0) do { s16x4 l0, l1, l2, l3, h0, h1, h2, h3; constexpr int b_ = OFF_V + VB * SHM_V + v_rd_off(d0, 0, 0); \
        TRRD(l0, b_); TRRD(h0, b_ + 2048); TRRD(l1, b_ + 4096); TRRD(h1, b_ + 6144); TRRD(l2, b_ + 8192); TRRD(h2, b_ + 10240); TRRD(l3, b_ + 12288); TRRD(h3, b_ + 14336); \
        asm volatile("s_waitcnt lgkmcnt(0)" ::: "memory"); SBAR(); \
        o[d0] = __builtin_amdgcn_mfma_f32_32x32x16_bf16(pa0, (bf16x8){l0[0], l0[1], l0[2], l0[3], h0[0], h0[1], h0[2], h0[3]}, o[d0], 0, 0, 0); \
        o[d0] = __builtin_amdgcn_mfma_f32_32x32x16_bf16(pa1, (bf16x8){l1[0], l1[1], l1[2], l1[3], h1[0], h1[1], h1[2], h1[3]}, o[d0], 0, 0, 0); \
        o[d0] = __builtin_amdgcn_mfma_f32_32x32x16_bf16(pa2, (bf16x8){l2[0], l2[1], l2[2], l2[3], h2[0], h2[1], h2[2], h2[3]}, o[d0], 0, 0, 0); \
        o[d0] = __builtin_amdgcn_mfma_f32_32x32x16_bf16(pa3, (bf16x8){l3[0], l3[1], l3[2], l3[3], h3[0], h3[1], h3[2], h3[3]}, o[d0], 0, 0, 0); } while (0)
    PV_D0(0); PV_D0(1); PV_D0(2); PV_D0(3);
#undef PV_D0
#undef TRRD
}
__device__ __forceinline__ void attn_block(const Ptrs& P, int b, int h, int qb, LAS char* lds) {
    const int tid = threadIdx.x, wid = __builtin_amdgcn_readfirstlane(tid >> 6), lane = tid & 63, r32 = lane & 31, hi = lane >> 5;
    const int i0 = qb * QB, P0 = NMETA + i0;
    const int NT = (P0 + QB - 1) / KVBLK + 1;
    const bf16* Qw = P.q_() + ((size_t)(b * NH + h) * SEQ + i0 + wid * QBLK + r32) * DQK;
    const __amdgpu_buffer_rsrc_t srdK = __builtin_amdgcn_make_buffer_rsrc((void*)(P.kn_() + (size_t)(b * NH + h) * LPAD * 128), (short)0, LPAD * 256, 0x00020000);
    const __amdgpu_buffer_rsrc_t srdV = __builtin_amdgcn_make_buffer_rsrc((void*)(P.v_() + (size_t)(b * NH + h) * LPAD * 128), (short)0, LPAD * 256, 0x00020000);
    const __amdgpu_buffer_rsrc_t srdR = __builtin_amdgcn_make_buffer_rsrc((void*)(P.kr_() + (size_t)b * LPAD * 64), (short)0, LPAD * 128, 0x00020000);
    bf16x8 qr[12];
#pragma unroll
    for (int d0 = 0; d0 < 12; ++d0) qr[d0] = *(const bf16x8*)(Qw + d0 * 16 + hi * 8);
    const int sr = tid >> 4, sc = (tid & 15) * 8, kws = KSWZ(sr, sc * 2), vst0 = v_st(sr, sc), vst1 = v_st(32 + sr, sc);
    const int rr = tid >> 3, rc = tid & 7, rws = RSWZ(rr, rc);
    const int qlo = P0 + wid * QBLK, qm = qlo + r32 - 4 * hi;
    LAS float* wsf = (LAS float*)(lds + OFF_WS) + wid * 64; LAS float* li_l = wsf; LAS float* al_l = wsf + 32;
    const int vb0 = (int)(uintptr_t)(lds) + v_rd_base(lane);
    float m_reg = -1e30f, l_reg = 0.f; f32x16 o[4] = {};
    bf16x8 st_k0, st_k1, st_v0, st_v1, st_r;
    const unsigned gofk = (unsigned)((tid >> 4) * 128 + (tid & 15) * 8) * 2u, gofr = (unsigned)((tid >> 3) * 64 + (tid & 7) * 8) * 2u;
#define BLD(rsrc, vo, so) __builtin_bit_cast(bf16x8, __builtin_amdgcn_raw_buffer_load_b128(rsrc, vo, so, 0))
#define SLOAD(t) do { const int so_ = (t) * (KVBLK * 256); \
        st_k0 = BLD(srdK, gofk, so_); st_k1 = BLD(srdK, gofk, so_ + 8192); st_v0 = BLD(srdV, gofk, so_); st_v1 = BLD(srdV, gofk, so_ + 8192); st_r = BLD(srdR, gofr, (t) * (KVBLK * 128)); } while (0)
#define SWRITE(bf) do { *(LAS bf16x8*)(lds + OFF_K + (bf) * SHM_K + kws) = st_k0; *(LAS bf16x8*)(lds + OFF_K + (bf) * SHM_K + kws + 32 * 256) = st_k1; \
        *(LAS bf16x8*)(lds + OFF_V + (bf) * SHM_V + vst0) = st_v0; *(LAS bf16x8*)(lds + OFF_V + (bf) * SHM_V + vst1) = st_v1; *(LAS bf16x8*)(lds + OFF_R + (bf) * SHM_R + rws) = st_r; } while (0)
    SLOAD(0); SWRITE(0);
    if (NT > 1) SLOAD(1);
    __syncthreads();
    f32x16 p0, p1; bf16x8 pa0, pa1, pa2, pa3;
#define STEP(t, BUF) do { \
        SBAR(); qkt<BUF>(p0, p1, lds, r32, hi, qr); \
        { const int kb_ = (t) * KVBLK; if (kb_ + KVBLK - 1 > qlo) { const int dq = qm - kb_; const float NEG = -__builtin_inff(); \
            _Pragma("unroll") for (int r = 0; r < 16; ++r) { const int c_ = (r & 3) + 8 * (r >> 2); if (dq - c_ < 0) p0[r] = NEG; if (dq - c_ - 32 < 0) p1[r] = NEG; } } } \
        float pmax = p0[0]; _Pragma("unroll") for (int r = 1; r < 16; ++r) pmax = fmaxf(pmax, p0[r]); _Pragma("unroll") for (int r = 0; r < 16; ++r) pmax = fmaxf(pmax, p1[r]); \
        { auto sw_ = __builtin_amdgcn_permlane32_swap(__float_as_uint(pmax), __float_as_uint(pmax), false, false); pmax = fmaxf(__uint_as_float(sw_[0]), __uint_as_float(sw_[1])); } \
        float alpha = 1.f; \
        if (!__all(pmax - m_reg <= THRL)) { const float mn = fmaxf(m_reg, pmax); alpha = __builtin_amdgcn_exp2f(m_reg - mn); m_reg = mn; } \
        _Pragma("unroll") for (int r = 0; r < 16; ++r) { p0[r] = __builtin_amdgcn_exp2f(p0[r] - m_reg); p1[r] = __builtin_amdgcn_exp2f(p1[r] - m_reg); } \
        float ps = 0.f; _Pragma("unroll") for (int r = 0; r < 16; ++r) ps += p0[r]; _Pragma("unroll") for (int r = 0; r < 16; ++r) ps += p1[r]; \
        { auto sw_ = __builtin_amdgcn_permlane32_swap(__float_as_uint(ps), __float_as_uint(ps), false, false); ps = __uint_as_float(sw_[0]) + __uint_as_float(sw_[1]); } \
        l_reg = l_reg * alpha + ps; \
        PK4(p0, 0, pa0); PK4(p0, 8, pa1); PK4(p1, 0, pa2); PK4(p1, 8, pa3); \
        if (__any(alpha < 1.f)) { if (hi == 0) al_l[r32] = alpha; asm volatile("s_waitcnt lgkmcnt(0)" ::: "memory"); \
            _Pragma("unroll") for (int d_ = 0; d_ < 4; ++d_) _Pragma("unroll") for (int r = 0; r < 16; ++r) o[d_][r] *= al_l[crow(r, hi)]; } \
        SBAR(); pv_tile<BUF>(o, vb0, pa0, pa1, pa2, pa3); SBAR(); \
        if ((t) + 1 < NT) SWRITE((BUF) ^ 1); \
        __syncthreads(); \
        if ((t) + 2 < NT) SLOAD((t) + 2); } while (0)
#define PK4(Pv, B_, OUT) do { const unsigned a0 = cvt_pk_bf16(Pv[B_ + 0], Pv[B_ + 1]), a1 = cvt_pk_bf16(Pv[B_ + 2], Pv[B_ + 3]), b0 = cvt_pk_bf16(Pv[B_ + 4], Pv[B_ + 5]), b1 = cvt_pk_bf16(Pv[B_ + 6], Pv[B_ + 7]); \
        auto r0 = __builtin_amdgcn_permlane32_swap(a0, b0, false, false); auto r1 = __builtin_amdgcn_permlane32_swap(a1, b1, false, false); \
        u32x4 w_ = {r0[0], r1[0], r0[1], r1[1]}; OUT = *reinterpret_cast<bf16x8*>(&w_); } while (0)
    int t = 0;
    for (; t + 1 < NT; t += 2) { STEP(t, 0); STEP(t + 1, 1); }
    if (t < NT) STEP(t, 0);
#undef STEP
#undef PK4
#undef SLOAD
#undef BLD
#undef SWRITE
    if (hi == 0) li_l[r32] = l_reg; asm volatile("s_waitcnt lgkmcnt(0)" ::: "memory");
    float rli[16];
#pragma unroll
    for (int r = 0; r < 16; ++r) rli[r] = __builtin_amdgcn_rcpf(li_l[crow(r, hi)]);
    bf16* Ow = P.o_() + ((size_t)(b * SEQ + i0 + wid * QBLK)) * DM + h * DV;
#pragma unroll
    for (int r = 0; r < 16; ++r) { const int orow = crow(r, hi);
#pragma unroll
        for (int d0 = 0; d0 < 4; ++d0) { const float v = o[d0][r] * rli[r]; const float vn = __shfl_xor(v, 1);
            if ((r32 & 1) == 0) *(unsigned*)(Ow + (size_t)orow * DM + d0 * 32 + r32) = cvt_pk_bf16(v, vn); } }
    __syncthreads();
}
#undef KSWZ
#undef RSWZ
}

#define XB_TMO      128
#define XB_XCNT(j)  (256  + 64 * (j))
#define XB_XSUB(j)  (1280 + 64 * (j))
#define XB_XGEN(j)  (2304 + 64 * (j))
#define XB_TOP      3328
#define XB_TOPGEN   3392
#define XCD_BAR_WORDS 3456
#define XB_SPIN_CAP (1u << 18)
__device__ __forceinline__ unsigned xb_ld(unsigned* p)              { return __hip_atomic_load(p, __ATOMIC_RELAXED, __HIP_MEMORY_SCOPE_AGENT); }
__device__ __forceinline__ unsigned xb_add(unsigned* p, unsigned v) { return __hip_atomic_fetch_add(p, v, __ATOMIC_RELAXED, __HIP_MEMORY_SCOPE_AGENT); }
__device__ __forceinline__ unsigned xb_xcc_id() { return (unsigned)__builtin_amdgcn_s_getreg((3 << 11) | 20) & 0xFu; }
#define XB_SPIN(cond, bar) do { unsigned _sp = 0; while (cond) { __builtin_amdgcn_s_sleep(1); \
    if ((++_sp & 255u) == 0u) { if (xb_ld(&(bar)[XB_TMO])) break; if (_sp > XB_SPIN_CAP) { atomicAdd(&(bar)[XB_TMO], 1u); break; } } } } while (0)
struct XcdBarrier { unsigned* bar; unsigned x; volatile LAS unsigned* st; };
__device__ __forceinline__ XcdBarrier xcd_barrier_post(unsigned* bar, volatile LAS unsigned* st) {
    XcdBarrier b; b.bar = bar; b.x = xb_xcc_id(); b.st = st;
    if (threadIdx.x == 0) (void)xb_add(&bar[XB_XCNT(b.x)], 1u);
    return b;
}
__device__ __forceinline__ void xcd_barrier_complete(unsigned* bar, unsigned x, unsigned& nloc, unsigned& nx) {
    const unsigned G = gridDim.x * gridDim.y * gridDim.z;
    unsigned sum, cnt, mine, sp = 0u;
    for (;;) {
        sum = 0u; cnt = 0u; mine = 0u;
#pragma unroll
        for (unsigned j = 0; j < 16; ++j) { const unsigned c = xb_ld(&bar[XB_XCNT(j)]); sum += c; cnt += (c > 0u) ? 1u : 0u; mine = (j == x) ? c : mine; }
        if (sum == G) break;
        __builtin_amdgcn_s_sleep(1);
        if ((++sp & 255u) == 0u) { if (xb_ld(&bar[XB_TMO])) break; if (sp > XB_SPIN_CAP) { atomicAdd(&bar[XB_TMO], 1u); break; } }
    }
    nloc = mine > 0u ? mine : 1u; nx = cnt > 0u ? cnt : 1u;
}
__device__ __forceinline__ void xcd_barrier(const XcdBarrier& b) {
    asm volatile("s_waitcnt vmcnt(0)" ::: "memory");
    __syncthreads();
    if (threadIdx.x == 0) {
        unsigned* bar = b.bar;
        __builtin_amdgcn_s_waitcnt(0);
        unsigned nloc = b.st[0], nx = b.st[1];
        if (nloc == 0u) { xcd_barrier_complete(bar, b.x, nloc, nx); b.st[0] = nloc; b.st[1] = nx; }
        const unsigned old = xb_add(&bar[XB_XSUB(b.x)], 1u);
        const unsigned gen = old / nloc;
        if (old + 1u == (gen + 1u) * nloc) {
            __builtin_amdgcn_fence(__ATOMIC_RELEASE, "agent");
            asm volatile("s_waitcnt vmcnt(0)" ::: "memory");
            const unsigned og = xb_add(&bar[XB_TOP], 1u);
            const unsigned tg = og / nx;
            if (og + 1u == (tg + 1u) * nx) xb_add(&bar[XB_TOPGEN], 1u);
            else XB_SPIN(xb_ld(&bar[XB_TOPGEN]) == tg, bar);
            __builtin_amdgcn_fence(__ATOMIC_ACQUIRE, "agent");
            xb_add(&bar[XB_XGEN(b.x)], 1u);
            asm volatile("s_waitcnt vmcnt(0)" ::: "memory");
        } else {
            XB_SPIN(xb_ld(&bar[XB_XGEN(b.x)]) == gen, bar);
            __builtin_amdgcn_fence(__ATOMIC_ACQUIRE, "agent");
            asm volatile("s_waitcnt vmcnt(0)" ::: "memory");
        }
    }
    __syncthreads();
}

enum { J_WIN = 0, J_WQ, J_WKV, J_WGLU, J_WAP, J_WOUT, J_WFFN, J_WDOWN };
struct ConvSrc { const float* p; };
template <int JOB> __device__ __forceinline__ const float* conv_src(const Ptrs& P, int r) {
    if constexpr (JOB == J_WIN) {
        if (r < 1024) return P.w_in_() + r;
        if (r < 2048) return P.w_in_() + 1088 + (r - 1024);
        if (r < 6144) return P.w_in_() + 2112 + (r - 2048);
        if (r < 6208) { const int rr = r - 6144, jp = rr >> 3, n = (rr >> 2) & 1, j = rr & 3; return P.w_in_() + 1024 + n * 32 + jp * 4 + j; }
        return nullptr;
    } else if constexpr (JOB == J_WQ) {
        if (r < 2048) return P.w_q_up_() + (r >> 7) * 192 + (r & 127);
        const int rr = r - 2048, h = rr >> 6, w = rr & 63, jp = w >> 3, n = (w >> 2) & 1, j = w & 3; return P.w_q_up_() + h * 192 + 128 + n * 32 + jp * 4 + j;
    } else if constexpr (JOB == J_WKV) { return P.w_kv_up_() + r;
    } else if constexpr (JOB == J_WGLU) { const int t = r >> 8, bj = (r >> 7) & 1, c = r & 127; return (bj ? P.w_glu_gate_() : P.w_glu_val_()) + t * 128 + c;
    } else if constexpr (JOB == J_WAP) { return P.w_attn_proj_() + r;
    } else if constexpr (JOB == J_WOUT) { return P.w_out_() + r;
    } else if constexpr (JOB == J_WFFN) { const int t = r >> 8, bj = (r >> 7) & 1, c = r & 127; return (bj ? P.w_ffn_up_() : P.w_ffn_gate_()) + t * 128 + c;
    } else { return P.w_ffn_down_() + r; }
}
template <int JOB> __device__ __forceinline__ void conv_item(const Ptrs& P, int item, int lane) {
    constexpr int K = (JOB == J_WIN || JOB == J_WAP || JOB == J_WOUT || JOB == J_WFFN) ? 2048 : (JOB == J_WQ || JOB == J_WKV) ? 512 : (JOB == J_WGLU) ? 1024 : 5632;
    constexpr int NOUT = (JOB == J_WIN) ? NWIN : (JOB == J_WQ) ? 3072 : (JOB == J_WKV || JOB == J_WGLU) ? 4096 : (JOB == J_WFFN) ? 11264 : 2048;
    constexpr int LDS_ = (JOB == J_WIN) ? INW : (JOB == J_WQ) ? 3072 : (JOB == J_WKV) ? 4096 : (JOB == J_WGLU || JOB == J_WAP || JOB == J_WOUT || JOB == J_WDOWN) ? 2048 : 5632;
    const float* gain = (JOB == J_WIN) ? P.norm_mix_() : (JOB == J_WQ) ? P.norm_q_() : (JOB == J_WKV) ? P.norm_kv_() : (JOB == J_WFFN) ? P.norm_ffn_() : nullptr;
    bf16* WT = (JOB == J_WIN) ? P.win_() : (JOB == J_WQ) ? P.wq_() : (JOB == J_WKV) ? P.wkv_() : (JOB == J_WGLU) ? P.wglu_() : (JOB == J_WAP) ? P.wap_() : (JOB == J_WOUT) ? P.wout_() : (JOB == J_WFFN) ? P.wffn_() : P.wdown_();
    constexpr int nblk = NOUT / 64; const int kb = item / nblk, nb = item % nblk, n0 = 64 * nb + 4 * (lane & 15), kk = 64 * kb + 16 * (lane >> 4);
    const float* src = conv_src<JOB>(P, n0);
    f32x4 v[16];
    if (src) { src += (size_t)kk * LDS_;
#pragma unroll
        for (int i = 0; i < 16; ++i) v[i] = *(const f32x4*)(src + (size_t)i * LDS_);
        if (gain) {
#pragma unroll
            for (int i = 0; i < 4; ++i) { const f32x4 g = *(const f32x4*)(gain + kk + 4 * i); v[4 * i] *= g[0]; v[4 * i + 1] *= g[1]; v[4 * i + 2] *= g[2]; v[4 * i + 3] *= g[3]; } } }
    else {
#pragma unroll
        for (int i = 0; i < 16; ++i) v[i] = (f32x4){0.f, 0.f, 0.f, 0.f}; }
#pragma unroll
    for (int j = 0; j < 4; ++j) { u32x4 o0, o1;
        o0.x = cvt_pk_bf16(v[0][j], v[1][j]); o0.y = cvt_pk_bf16(v[2][j], v[3][j]); o0.z = cvt_pk_bf16(v[4][j], v[5][j]); o0.w = cvt_pk_bf16(v[6][j], v[7][j]);
        o1.x = cvt_pk_bf16(v[8][j], v[9][j]); o1.y = cvt_pk_bf16(v[10][j], v[11][j]); o1.z = cvt_pk_bf16(v[12][j], v[13][j]); o1.w = cvt_pk_bf16(v[14][j], v[15][j]);
        bf16* d = WT + (size_t)(n0 + j) * K + kk; *(u32x4*)d = o0; *(u32x4*)(d + 8) = o1; }
}
constexpr int conv_items(int K, int NOUT) { return (K / 64) * (NOUT / 64); }
__device__ __forceinline__ float wave_sum(float v) {
#pragma unroll
    for (int o = 1; o < 64; o <<= 1) v += __shfl_xor(v, o);
    return v;
}
__device__ __forceinline__ void ssm_build(const Ptrs& P, int g, int part, LAS unsigned char* lds) {
    LAS f32x2* apw = (LAS f32x2*)lds;
    LAS f32x2* bb = (LAS f32x2*)(lds + 17 * 64 * 8);
    LAS f32x2* cc = bb + 64 * 16;
    LAS float* ktab = (LAS float*)(cc + 16 * 64);
    const int tid = threadIdx.x;
    const float step = expf(P.log_step_()[g]);
    if (tid < 64) { const int n = tid; const float lr = P.lam_re_()[g * 64 + n], li = P.lam_im_()[g * 64 + n];
        const float th = li * step, lm = lr * step;
        for (int k = 0; k <= 16; ++k) { const float mag = expf((float)k * lm); float sn, cs; sincosf((float)k * th, &sn, &cs); const f32x2 a = {mag * cs, mag * sn}; apw[k * 64 + n] = a; if (part == 0) P.apow_()[((size_t)g * 17 + k) * 64 + n] = a; }
        const float mag1 = expf(lm); float s1, c1; sincosf(th, &s1, &c1); const float abr = mag1 * c1, abi = mag1 * s1;
        const float den = lr * lr + li * li, nr = abr - 1.0f, ni = abi; const float cr = (nr * lr + ni * li) / den, ci = (ni * lr - nr * li) / den;
        for (int q = 0; q < 16; ++q) { const float br = P.b_re_()[((size_t)g * 64 + n) * 16 + q], bi = P.b_im_()[((size_t)g * 64 + n) * 16 + q];
            const f32x2 w = {cr * br - ci * bi, cr * bi + ci * br}; bb[n * 16 + q] = w; if (part == 0) P.bbar_()[((size_t)g * 64 + n) * 16 + q] = w; } }
    for (int e = tid; e < 1024; e += 512) { const int p = e >> 6, n = e & 63; cc[e] = (f32x2){P.c_re_()[((size_t)g * 16 + p) * 64 + n], P.c_im_()[((size_t)g * 16 + p) * 64 + n]}; }
    __syncthreads();
    for (int e = tid; e < 4096; e += 512) { const int k = e >> 8, p = (e >> 4) & 15, q = e & 15; float acc = 0.f;
        for (int n = 0; n < 64; ++n) { const f32x2 a = apw[k * 64 + n], b = bb[n * 16 + q], c = cc[p * 64 + n];
            const float wr_ = a.x * b.x - a.y * b.y, wi_ = a.x * b.y + a.y * b.x; acc += c.x * wr_ - c.y * wi_; }
        if (k == 0 && p == q) acc += P.ssm_d_()[g * 16 + p];
        ktab[e] = acc; }
    __syncthreads();
    bf16* bty = P.bty_() + (size_t)g * 256 * KY;
    for (int e = tid; e < 64 * KY / 2; e += 512) { const int row = part * 64 + (2 * e) / KY, col = (2 * e) % KY; const int t = row >> 4, p = row & 15; float v[2];
#pragma unroll
        for (int z = 0; z < 2; ++z) { const int cl = col + z;
            if (cl < 256) { const int s = cl >> 4, q = cl & 15; v[z] = (s <= t) ? ktab[((t - s) * 16 + p) * 16 + q] : 0.f; }
            else { const int n = (cl - 256) & 63; const f32x2 a = apw[(t + 1) * 64 + n], c = cc[p * 64 + n]; v[z] = (cl < 320) ? (c.x * a.x - c.y * a.y) : -(c.x * a.y + c.y * a.x); } }
        *(unsigned*)(bty + (size_t)row * KY + col) = cvt_pk_bf16(v[0], v[1]); }
    bf16* bts = P.bts_() + (size_t)g * 128 * KS;
    for (int e = tid; e < 32 * KS / 2; e += 512) { const int row = part * 32 + (2 * e) / KS, col = (2 * e) % KS; const int n = row & 63; float v[2];
#pragma unroll
        for (int z = 0; z < 2; ++z) { const int cl = col + z, s = cl >> 4, q = cl & 15; const f32x2 a = apw[(15 - s) * 64 + n], b = bb[n * 16 + q];
            v[z] = (row < 64) ? (a.x * b.x - a.y * b.y) : (a.x * b.y + a.y * b.x); }
        *(unsigned*)(bts + (size_t)row * KS + col) = cvt_pk_bf16(v[0], v[1]); }
    __syncthreads();
}

__global__ void __launch_bounds__(NWAVES * 64, 2) hybrid_fwd(Args args) {
    extern __shared__ __attribute__((aligned(16))) unsigned char lds_raw[];
    LAS unsigned char* lds = (LAS unsigned char*)lds_raw;
    volatile LAS unsigned* MISC = (volatile LAS unsigned*)(lds + MISC_OFF);
    const int tid = threadIdx.x, lane = tid & 63, wave = __builtin_amdgcn_readfirstlane(tid >> 6);
    const int G = gridDim.x; const int bx = blockIdx.x; const int vcu = (G % 8 == 0) ? (bx % 8) * (G / 8) + bx / 8 : bx;
    const Ptrs P(args);
    for (int u = tid; u < (LDS_BYTES - LDSCTL_OFF) / 4; u += NWAVES * 64) ((LAS unsigned*)(lds + LDSCTL_OFF))[u] = 0u;
    __syncthreads();
    XcdBarrier bar; bar.bar = P.ctl_() + CW_BAR; bar.x = 0; bar.st = nullptr;
    if (!MK_SPLIT) bar = xcd_barrier_post(P.ctl_() + CW_BAR, MISC + 8);
    const int lo = args.ph_lo, hi = args.ph_hi;
#define IN(k) (lo <= (k) && (k) < hi)
#define SEAM(k) do { if (IN(k) && IN((k) + 1)) xcd_barrier(bar); } while (0)
    const int gw = vcu * NWAVES + wave, NGW = G * NWAVES;
    const int gt = vcu * (NWAVES * 64) + tid, NGT = G * NWAVES * 64;

    if (IN(0)) for (int rep0_ = 0; rep0_ < 1 + PROBE_CNT(0); ++rep0_) {
        __syncthreads();
        if (vcu < 4 * NG) ssm_build(P, vcu >> 2, vcu & 3, lds);
        {
            constexpr int I0 = conv_items(2048, NWIN), I1 = conv_items(512, 3072), I2 = conv_items(512, 4096), I3 = conv_items(1024, 4096), I4 = conv_items(2048, 2048);
            for (int it = gw; it < I0 + I1 + I2 + I3 + I4; it += NGW) { int r = it;
                if (r < I0) { conv_item<J_WIN>(P, r, lane); continue; } r -= I0;
                if (r < I1) { conv_item<J_WQ>(P, r, lane); continue; } r -= I1;
                if (r < I2) { conv_item<J_WKV>(P, r, lane); continue; } r -= I2;
                if (r < I3) { conv_item<J_WGLU>(P, r, lane); continue; } r -= I3;
                conv_item<J_WAP>(P, r, lane); }
        }
        for (int m = gw; m < MROWS; m += NGW) {
            GAS u32x2* o8 = (GAS u32x2*)(P.xb_() + (size_t)m * DM) + lane;
            if (m < MTOK + NMETA) { const float* xr = (m < MTOK) ? P.x_() + (size_t)m * DM : P.meta_() + (size_t)(m - MTOK) * DM;
                f32x4 v[8]; float s = 0.f;
#pragma unroll
                for (int j = 0; j < 8; ++j) { v[j] = *((const GAS f32x4*)xr + lane + 64 * j); s += (v[j][0] * v[j][0] + v[j][1] * v[j][1]) + (v[j][2] * v[j][2] + v[j][3] * v[j][3]); }
                s = wave_sum(s); if (lane == 0) P.rs1_()[m] = rsqrtf(s * (1.0f / DM) + EPS);
#pragma unroll
                for (int j = 0; j < 8; ++j) { u32x2 w; w.x = cvt_pk_bf16(v[j][0], v[j][1]); w.y = cvt_pk_bf16(v[j][2], v[j][3]); o8[64 * j] = w; } }
            else { if (lane == 0) P.rs1_()[m] = 1.0f;
#pragma unroll
                for (int j = 0; j < 8; ++j) o8[64 * j] = (u32x2){0u, 0u}; }
        }
        for (int e = gt; e < LTOT * 32; e += NGT) { const int pos = e >> 5, i = e & 31; const float fr_ = (float)pow(10000.0, -(double)i / 32.0); const float ang = (float)pos * fr_;
            P.cs_()[e] = (f32x2){(float)cos((double)ang), (float)sin((double)ang)}; }
        for (int e = gt; e < NBATCH * NH * (LPAD - LTOT) * 16; e += NGT) { const int bh = e / ((LPAD - LTOT) * 16), r = e % ((LPAD - LTOT) * 16); const size_t off = ((size_t)bh * LPAD + LTOT) * 128 + (size_t)r * 8;
            *(u32x4*)(P.kn_() + off) = (u32x4){0u, 0u, 0u, 0u}; *(u32x4*)(P.v_() + off) = (u32x4){0u, 0u, 0u, 0u}; }
        for (int e = gt; e < NBATCH * (LPAD - LTOT) * 8; e += NGT) { const int b = e / ((LPAD - LTOT) * 8), r = e % ((LPAD - LTOT) * 8); *(u32x4*)(P.kr_() + ((size_t)b * LPAD + LTOT) * 64 + (size_t)r * 8) = (u32x4){0u, 0u, 0u, 0u}; }
        for (int e = gt; e < 128 * KS / 8; e += NGT) *(u32x4*)(P.bts_() + (size_t)NG * 128 * KS + (size_t)e * 8) = (u32x4){0u, 0u, 0u, 0u};
    }
    SEAM(0);
    if (IN(1)) { Sched<1> S(P, G, bx); Epi<1> E(P); pg8::gemm_run(lds, S, E);
        for (int rep_ = 0; rep_ < PROBE_CNT(1); ++rep_) { __syncthreads(); Epi<1> E2(P, true); pg8::gemm_run(lds, S, E2); } }
    SEAM(1);
    if (IN(2)) for (int rep2_ = 0; rep2_ < 1 + PROBE_CNT(2); ++rep2_) {
        __syncthreads();
        if (vcu < 8) { const int e = vcu * 512 + tid, g = e >> 6, n = e & 63; float xr = 0.f, xi = 0.f;
            for (int s = 0; s < NMETA; ++s) { const f32x2 a = P.apow_()[((size_t)g * 17 + (15 - s)) * 64 + n]; float br = 0.f, bi = 0.f;
                for (int q = 0; q < 16; ++q) { const f32x2 w = P.bbar_()[((size_t)g * 64 + n) * 16 + q]; const float uu = P.umeta_()[s * 1024 + g * 16 + q]; br += w.x * uu; bi += w.y * uu; }
                xr += a.x * br - a.y * bi; xi += a.x * bi + a.y * br; }
            P.x0_()[e] = (f32x2){xr, xi}; }
        Sched<2> S(P, G, bx); Epi<2> E(P); pg8::gemm_run(lds, S, E);
    }
    SEAM(2);
    if (IN(3)) {
        {
            const int w = vcu; const int b = w >> 7, g = (w >> 1) & 63, n = (w & 1) * 32 + (tid & 31), seg = tid >> 5;
            if (w < 256) {
                const f32x2 A16 = P.apow_()[((size_t)g * 17 + 16) * 64 + n];
                f32x2 A256 = A16;
#pragma unroll
                for (int z = 0; z < 4; ++z) A256 = (f32x2){A256.x * A256.x - A256.y * A256.y, 2.f * A256.x * A256.y};
                const float* sl = P.sloc_() + ((size_t)(g * 512 + b * 256 + seg * 16)) * 128 + n;
                float sre[16], sim[16];
#pragma unroll
                for (int j = 0; j < 16; ++j) { sre[j] = sl[j * 128]; sim[j] = sl[j * 128 + 64]; }
                float tr = 0.f, ti = 0.f;
#pragma unroll
                for (int j = 0; j < 16; ++j) { const float nr = A16.x * tr - A16.y * ti + sre[j], ni = A16.x * ti + A16.y * tr + sim[j]; tr = nr; ti = ni; }
                LAS f32x2* T = (LAS f32x2*)lds;
                T[seg * 32 + (tid & 31)] = (f32x2){tr, ti};
                __syncthreads();
                const f32x2 x0v = P.x0_()[g * 64 + n]; float xr = x0v.x, xi = x0v.y;
                for (int s2 = 0; s2 < seg; ++s2) { const f32x2 tv = T[s2 * 32 + (tid & 31)]; const float nr = A256.x * xr - A256.y * xi + tv.x, ni = A256.x * xi + A256.y * xr + tv.y; xr = nr; xi = ni; }
                bf16* ua = P.ua_() + ((size_t)(g * 512 + b * 256 + seg * 16)) * KY + 256 + n;
#pragma unroll
                for (int j = 0; j < 16; ++j) { ua[(size_t)j * KY] = (bf16)(cvt_pk_bf16(xr, 0.f) & 0xffffu); ua[(size_t)j * KY + 64] = (bf16)(cvt_pk_bf16(xi, 0.f) & 0xffffu);
                    const float nr = A16.x * xr - A16.y * xi + sre[j], ni = A16.x * xi + A16.y * xr + sim[j]; xr = nr; xi = ni; }
            }
            __syncthreads();
        }
        for (int rep_ = 0; rep_ < PROBE_ATT; ++rep_)
        for (int it = vcu; it < 256; it += G) { const int bh = it >> 3, xq = it & 7;
            for (int pass = 0; pass < 2; ++pass) att::attn_block(P, bh >> 4, bh & 15, pass ? 15 - xq : xq, (LAS char*)lds); }
    }
    SEAM(3);
    if (IN(4)) for (int rep4_ = 0; rep4_ < 1 + PROBE_CNT(4); ++rep4_) {
        __syncthreads();
        constexpr int I0 = conv_items(2048, 2048), I1 = conv_items(2048, 11264), I2 = conv_items(5632, 2048);
        {
            const bool heavy = bx < 128; const int nsl = heavy ? 2 : 3; const int s0 = heavy ? (bx * NWAVES + wave) * 2 : 128 * NWAVES * 2 + ((bx - 128) * NWAVES + wave) * 3;
            const int NSL = 128 * NWAVES * 2 + (G - 128) * NWAVES * 3;
            for (int base = 0; base < I0 + I1 + I2; base += NSL)
                for (int k = 0; k < nsl; ++k) { int r = base + s0 + k; if (r >= I0 + I1 + I2) break;
                    if (r < I0) { conv_item<J_WOUT>(P, r, lane); continue; } r -= I0;
                    if (r < I1) { conv_item<J_WFFN>(P, r, lane); continue; } r -= I1;
                    conv_item<J_WDOWN>(P, r, lane); }
        }
        __syncthreads();
        Sched<4> S(P, G, bx); Epi<4> E(P); pg8::gemm_run(lds, S, E);
    }
    SEAM(4);
    if (IN(5)) { Sched<5> S(P, G, bx); Epi<5> E(P); pg8::gemm_run(lds, S, E);
        for (int rep_ = 0; rep_ < PROBE_CNT(5); ++rep_) { __syncthreads(); Epi<5> E2(P, false); pg8::gemm_run(lds, S, E2); } }
    SEAM(5);
    if (IN(6)) { Sched<6> S(P, G, bx); Epi<6> E(P); pg8::gemm_run(lds, S, E);
        for (int rep_ = 0; rep_ < PROBE_CNT(6); ++rep_) { __syncthreads(); Epi<6> E2(P, false); pg8::gemm_run(lds, S, E2); } }
    SEAM(6);
    if (IN(7)) { Sched<7> S(P, G, bx); Epi<7> E(P); pg8::gemm_run(lds, S, E);
        for (int rep_ = 0; rep_ < PROBE_CNT(7); ++rep_) { __syncthreads(); Epi<7> E2(P, true); pg8::gemm_run(lds, S, E2); } }
    SEAM(7);
    if (IN(8)) { Sched<8> S(P, G, bx); Epi<8> E(P); pg8::gemm_run(lds, S, E);
        for (int rep_ = 0; rep_ < PROBE_CNT(8); ++rep_) { __syncthreads(); Epi<8> E2(P, false); pg8::gemm_run(lds, S, E2); } }
    SEAM(8);
    if (IN(9)) { Sched<9> S(P, G, bx); Epi<9> E(P); pg8::gemm_run(lds, S, E);
        for (int rep_ = 0; rep_ < PROBE_CNT(9); ++rep_) { __syncthreads(); Epi<9> E2(P, true); pg8::gemm_run(lds, S, E2); } }
    SEAM(9);
    if (IN(10)) {
        const bool bad = __hip_atomic_load(P.ctl_() + CW_BAR + XB_TMO, RLX_AGENT) != 0u;
        unsigned lane_ = threadIdx.x; asm volatile("" : "+v"(lane_)); lane_ &= 63u;
        for (int m = gw; m < MTOK; m += NGW) { const float rs = bad ? __builtin_nanf("") : rsqrtf(P.ssq_h2_()[m] * (1.0f / DM) + EPS);
            GAS f32x4* o = (GAS f32x4*)(P.out_() + (size_t)m * DM) + lane_;
#pragma unroll
            for (int j = 0; j < 8; ++j) { const f32x4 g = *((const GAS f32x4*)P.norm_final_() + lane_ + 64 * j); o[64 * j] = o[64 * j] * rs * g; } }
    }
#undef IN
#undef SEAM
}

extern "C" void kernel_launch(void* const* d_in, const int* in_sizes, int n_in, void* d_out, int out_size, void* d_ws, size_t ws_size, hipStream_t stream) {
    static int grid = 0;
    if (grid == 0) {
        if (n_in != 25 || in_sizes[0] != MTOK * DM || out_size != MTOK * DM || ws_size < WS_END) {
            fprintf(stderr, "kernel_launch: unexpected shapes (n_in %d, in0 %d, out %d, ws %zu < %zu)\n", n_in, n_in > 0 ? in_sizes[0] : -1, out_size, ws_size, (size_t)WS_END); grid = -1; return; }
        int dev = 0, cus = 0, per_cu = 0;
        if (hipGetDevice(&dev) != hipSuccess || hipDeviceGetAttribute(&cus, hipDeviceAttributeMultiprocessorCount, dev) != hipSuccess) { grid = -1; return; }
        if (hipFuncSetAttribute((const void*)hybrid_fwd, hipFuncAttributeMaxDynamicSharedMemorySize, LDS_BYTES) != hipSuccess) { fprintf(stderr, "kernel_launch: hipFuncSetAttribute failed\n"); grid = -1; return; }
        if (hipOccupancyMaxActiveBlocksPerMultiprocessor(&per_cu, (const void*)hybrid_fwd, NWAVES * 64, LDS_BYTES) != hipSuccess || per_cu < 1) {
            fprintf(stderr, "kernel_launch: occupancy query reports %d workgroups per CU\n", per_cu); (void)hipGetLastError(); grid = -1; return; }
        grid = cus;
    }
    if (grid < 0) return;
    if (hipMemsetAsync((char*)d_ws + WS_CTL, 0, CTL_ZERO_BYTES, stream) != hipSuccess) { fprintf(stderr, "kernel_launch: memset failed\n"); return; }
    Args a{};
    for (int i = 0; i < 25; ++i) a.in[i] = (const float*)d_in[i];
    a.out = (float*)d_out; a.ws = (unsigned char*)d_ws;
#if MK_SPLIT
    for (int ph = 0; ph < N_PHASES; ++ph) { a.ph_lo = ph; a.ph_hi = ph + 1; hipLaunchKernelGGL(hybrid_fwd, dim3(grid), dim3(NWAVES * 64), LDS_BYTES, stream, a); }
#else
    a.ph_lo = 0; a.ph_hi = N_PHASES;
    hipLaunchKernelGGL(hybrid_fwd, dim3(grid), dim3(NWAVES * 64), LDS_BYTES, stream, a);
#endif
    const hipError_t le = hipPeekAtLastError();
    if (le != hipSuccess) fprintf(stderr, "kernel_launch: launch failed: %s\n", hipGetErrorName(le));
}
```

```cpp
#include <hip/hip_runtime.h>
#include <cstdio>
#include <cstdint>

#define LAS __attribute__((address_space(3)))
#define GAS __attribute__((address_space(1)))
typedef unsigned short bf16;
typedef short bf16x8 __attribute__((ext_vector_type(8)));
typedef short s16x4 __attribute__((ext_vector_type(4)));
typedef float f32x2 __attribute__((ext_vector_type(2)));
typedef float f32x4 __attribute__((ext_vector_type(4)));
typedef float f32x16 __attribute__((ext_vector_type(16)));
typedef unsigned u32x2 __attribute__((ext_vector_type(2)));
typedef unsigned u32x4 __attribute__((ext_vector_type(4)));

#ifndef PROBE_ATT
#define PROBE_ATT 1
#endif
#ifndef PROBE_PH
#define PROBE_PH -1
#endif
#ifndef PROBE_N
#define PROBE_N 0
#endif
#define PROBE_CNT(k) ((PROBE_PH == (k)) ? PROBE_N : 0)
#ifndef MK_SPLIT
#define MK_SPLIT 0
#endif

constexpr int DM = 2048, SEQ = 4096, NBATCH = 2, NMETA = 16, LTOT = SEQ + NMETA, LPAD = 4160;
constexpr int MTOK = NBATCH * SEQ;
constexpr int MROWS = MTOK + 256;
constexpr int NH = 16, DQK = 192, DNOPE = 128, DROPE = 64, DV = 128, QLORA = 512, KVLORA = 512;
constexpr int SSMW = 1024, NG = 64, NS = 64, TC = 16, NCH = SEQ / TC  , KY = 384, KS = 256;
constexpr int DFF = 5632, INW = 6208, NWIN = 6208;
constexpr float EPS = 1e-6f;
constexpr float QSCALE = 0.07216878364870322f * 1.4426950408889634f;
constexpr int NWAVES = 8;
constexpr int N_PHASES = 11;

constexpr size_t MiB = 1u << 20;
constexpr size_t WS_CTL = 0, CTL_ZERO_BYTES = 1 * MiB;
constexpr int CW_TMO = 0, CW_BAR = 4096;
constexpr size_t OFF_SSQ_Q = 64 * 1024, OFF_SSQ_KV = 128 * 1024, OFF_SSQ_H1 = 192 * 1024, OFF_SSQ_H2 = 256 * 1024;
constexpr size_t WS_RS1 = 1 * MiB;
constexpr size_t WS_CS = 1 * MiB + 64 * 1024;
constexpr size_t WS_APOW = 2 * MiB + 256 * 1024;
constexpr size_t WS_BBAR = 3 * MiB;
constexpr size_t WS_X0 = 3 * MiB + 512 * 1024;
constexpr size_t WS_UMETA = 3 * MiB + 576 * 1024;
constexpr size_t WS_WIN = 4 * MiB;
constexpr size_t WS_SLOC = 4 * MiB;
constexpr size_t WS_P = 4 * MiB;
constexpr size_t WS_H1B = 4 * MiB;
constexpr size_t WS_WQ = 29 * MiB;
constexpr size_t WS_WKV = 32 * MiB;
constexpr size_t WS_BTS = 36 * MiB;
constexpr size_t WS_BTY = 41 * MiB;
constexpr size_t WS_WGLU = 53 * MiB;
constexpr size_t WS_WAP = 61 * MiB;
constexpr size_t WS_F = 36 * MiB;
constexpr size_t WS_XB = 69 * MiB;
constexpr size_t WS_O = 69 * MiB;
constexpr size_t WS_UA = 102 * MiB;
constexpr size_t WS_MIXED = 102 * MiB;
constexpr size_t WS_QLAT = 126 * MiB;
constexpr size_t WS_Y = 126 * MiB;
constexpr size_t WS_KVLAT = 134 * MiB;
constexpr size_t WS_KR = 143 * MiB;
constexpr size_t WS_Q = 145 * MiB;
constexpr size_t WS_KN = 193 * MiB;
constexpr size_t WS_V = 226 * MiB;
constexpr size_t WS_WOUT = 170 * MiB;
constexpr size_t WS_WFFN = 178 * MiB;
constexpr size_t WS_WDOWN = 222 * MiB;
constexpr size_t WS_END = 259 * MiB;
static_assert(WS_WDOWN + (size_t)2048 * 5632 * 2 <= 244 * MiB && WS_V + (size_t)2 * 16 * 4160 * 128 * 2 <= WS_END, "ws map");
static_assert(WS_F + (size_t)8192 * 5632 * 2 <= WS_QLAT && WS_UA + (size_t)NG * 512 * KY * 2 <= WS_QLAT, "ws map 2");

constexpr int RING_BYTES = 131072;
constexpr int LDSCTL_OFF = RING_BYTES, MISC_OFF = LDSCTL_OFF + 320;
constexpr int LDS_BYTES = 147456;

#define RLX_AGENT __ATOMIC_RELAXED, __HIP_MEMORY_SCOPE_AGENT
#define LDS_WAIT() asm volatile("s_waitcnt lgkmcnt(0)" ::: "memory")
#define VM_WAIT() asm volatile("s_waitcnt vmcnt(0)" ::: "memory")
#define SBAR() __builtin_amdgcn_sched_barrier(0)
__device__ __forceinline__ unsigned cvt_pk_bf16(float lo, float hi) { unsigned r; asm volatile("v_cvt_pk_bf16_f32 %0, %1, %2" : "=v"(r) : "v"(lo), "v"(hi)); return r; }
__device__ __forceinline__ float bf_lo(unsigned w) { return __uint_as_float(w << 16); }
__device__ __forceinline__ float bf_hi(unsigned w) { return __uint_as_float(w & 0xffff0000u); }
__device__ __forceinline__ float fast_sigmoid(float x) { return __builtin_amdgcn_rcpf(1.0f + __builtin_amdgcn_exp2f(-1.4426950408889634f * x)); }
__device__ __forceinline__ float gelu_tanh(float x) { const float z = 0.7978845608028654f * (x + 0.044715f * x * x * x); return x * fast_sigmoid(2.0f * z); }
__device__ __forceinline__ u32x4 pack8(const f32x4 a, const f32x4 b) { u32x4 w; w.x = cvt_pk_bf16(a[0], a[1]); w.y = cvt_pk_bf16(a[2], a[3]); w.z = cvt_pk_bf16(b[0], b[1]); w.w = cvt_pk_bf16(b[2], b[3]); return w; }
__device__ __forceinline__ void unpack8(const u32x4 w, f32x4& a, f32x4& b) { a = (f32x4){bf_lo(w.x), bf_hi(w.x), bf_lo(w.y), bf_hi(w.y)}; b = (f32x4){bf_lo(w.z), bf_hi(w.z), bf_lo(w.w), bf_hi(w.w)}; }

struct Args { const float* in[25]; float* out; unsigned char* ws; int ph_lo, ph_hi; };
struct PtrsT {
    const Args& a;
    __device__ __forceinline__ explicit PtrsT(const Args& a_) : a(a_) {}
#define PIN(name, idx) __device__ __forceinline__ const float* name##_() const { return a.in[idx]; }
    PIN(x, 0) PIN(meta, 1) PIN(norm_mix, 2) PIN(w_in, 3) PIN(norm_q, 4) PIN(w_q_up, 5) PIN(norm_kv, 6) PIN(w_kv_up, 7) PIN(w_attn_proj, 8) PIN(lam_re, 9) PIN(lam_im, 10) PIN(log_step, 11)
    PIN(b_re, 12) PIN(b_im, 13) PIN(c_re, 14) PIN(c_im, 15) PIN(ssm_d, 16) PIN(w_glu_val, 17) PIN(w_glu_gate, 18) PIN(w_out, 19) PIN(norm_ffn, 20) PIN(w_ffn_gate, 21) PIN(w_ffn_up, 22)
    PIN(w_ffn_down, 23) PIN(norm_final, 24)
#undef PIN
#define PWS(type, name, off) __device__ __forceinline__ type* name##_() const { return (type*)(a.ws + (off)); }
    PWS(unsigned, ctl, WS_CTL) PWS(float, ssq_q, OFF_SSQ_Q) PWS(float, ssq_kv, OFF_SSQ_KV) PWS(float, ssq_h1, OFF_SSQ_H1) PWS(float, ssq_h2, OFF_SSQ_H2) PWS(float, rs1, WS_RS1) PWS(float, umeta, WS_UMETA)
    PWS(float, sloc, WS_SLOC) PWS(f32x2, cs, WS_CS) PWS(f32x2, apow, WS_APOW) PWS(f32x2, bbar, WS_BBAR) PWS(f32x2, x0, WS_X0)
    PWS(bf16, win, WS_WIN) PWS(bf16, wq, WS_WQ) PWS(bf16, wkv, WS_WKV) PWS(bf16, bts, WS_BTS) PWS(bf16, bty, WS_BTY) PWS(bf16, wglu, WS_WGLU) PWS(bf16, wap, WS_WAP) PWS(bf16, wout, WS_WOUT)
    PWS(bf16, wffn, WS_WFFN) PWS(bf16, wdown, WS_WDOWN) PWS(bf16, xb, WS_XB) PWS(bf16, qlat, WS_QLAT) PWS(bf16, kvlat, WS_KVLAT) PWS(bf16, ua, WS_UA) PWS(bf16, kr, WS_KR) PWS(bf16, q, WS_Q)
    PWS(bf16, kn, WS_KN) PWS(bf16, v, WS_V) PWS(bf16, o, WS_O) PWS(bf16, y, WS_Y) PWS(bf16, pbuf, WS_P) PWS(bf16, mixed, WS_MIXED) PWS(bf16, h1b, WS_H1B) PWS(bf16, f, WS_F)
#undef PWS
    __device__ __forceinline__ float* out_() const { return a.out; }
    __device__ __forceinline__ bf16* sg_() const { return (bf16*)a.out; }
};
typedef PtrsT Ptrs;

namespace pg8 {
constexpr int BM = 256, BK = 64, HALF = 128, HTB = HALF * BK * 2, STAGE_BYTES = 8 * HTB, NXCD = 8, WGM = 8;
__host__ __device__ __forceinline__ int lds_byte(int r, int c) { const int st = (r >> 4) * 2 + (c >> 5), rr = r & 15, cc = c & 31, ob = rr * 64 + cc * 2; return st * 1024 + (ob ^ (((ob >> 9) & 1) << 5)); }
__host__ __device__ __forceinline__ void stage_rc(int b, int& R, int& C) { const int st = b / 1024, sb = b % 1024, swz = sb ^ (((sb >> 9) & 1) << 5); R = (st >> 1) * 16 + swz / 64; C = (st & 1) * 32 + (swz % 64) / 2; }
__host__ __device__ __forceinline__ int perm32(int rho) { const int n = rho >> 4, i = rho & 15; return 8 * (i >> 2) + 4 * n + (i & 3); }

struct Unit { const char* A; const char* B; unsigned lda, ldb; int nt, pm, pn, kind, aux; };

__device__ __forceinline__ void tile_order(int L, int nM, int nN, int& pm, int& pn) {
    const int nwg = nM * nN; int wgid = L;
    { const int q = nwg / NXCD, r = nwg % NXCD, xcd = wgid % NXCD, off = wgid / NXCD; wgid = (xcd < r ? xcd * (q + 1) : r * (q + 1) + (xcd - r) * q) + off; }
    const int nig = WGM * nN, gid = wgid / nig, fm = gid * WGM, gsz = (nM - fm) < WGM ? (nM - fm) : WGM;
    pm = fm + ((wgid % nig) % gsz); pn = (wgid % nig) / gsz;
}

template <class Sched, class Epi>
__device__ __forceinline__ void gemm_run(LAS unsigned char* lds, const Sched& S, const Epi& E) {
    const int tid = threadIdx.x, wid = __builtin_amdgcn_readfirstlane(tid >> 6), lane = tid & 63, wr = wid >> 2, wc = wid & 3, fr = lane & 15, fq = lane >> 4;
    unsigned RA[2], RB[2], C2[2];
#pragma unroll
    for (int i = 0; i < 2; ++i) { int R, C; stage_rc(tid * 16 + i * 8192, R, C); RA[i] = (unsigned)R; RB[i] = (unsigned)((R & ~31) + perm32(R & 31)); C2[i] = (unsigned)(C * 2); }
    const unsigned ldsw = (unsigned)wid * 1024u;
    const int aoff = lds_byte(wr * 64 + fr, fq * 8), boff = lds_byte(wc * 32 + fr, fq * 8);
#define PG8_SA(b, h) (((b) * 2 + (h)) * HTB)
#define PG8_SB(b, h) ((4 + (b) * 2 + (h)) * HTB)
#define PG8_STAGE(bufoff, gbase, RR, ld) do { _Pragma("unroll") for (int _i = 0; _i < 2; ++_i) \
        __builtin_amdgcn_global_load_lds((const unsigned*)((const char*)(gbase) + (RR)[_i] * (ld) + C2[_i]), (LAS unsigned*)(lds + (bufoff) + ldsw + _i * 8192), 16, 0, 0); } while (0)
#define PG8_LDA(dst, b, h) do { _Pragma("unroll") for (int m = 0; m < 4; ++m) _Pragma("unroll") for (int k = 0; k < 2; ++k) dst[m][k] = *(const LAS bf16x8*)(lds + PG8_SA(b, h) + aoff + m * 2048 + k * 1024); } while (0)
#define PG8_LDB(dst, b, h) do { _Pragma("unroll") for (int n = 0; n < 2; ++n) _Pragma("unroll") for (int k = 0; k < 2; ++k) dst[n][k] = *(const LAS bf16x8*)(lds + PG8_SB(b, h) + boff + n * 2048 + k * 1024); } while (0)
#define PG8_MMA(ai, bj, At, Bt) do { __builtin_amdgcn_s_setprio(1); _Pragma("unroll") for (int m = 0; m < 4; ++m) _Pragma("unroll") for (int n = 0; n < 2; ++n) _Pragma("unroll") for (int k = 0; k < 2; ++k) \
        acc[ai][bj][m][n] = __builtin_amdgcn_mfma_f32_16x16x32_bf16(Bt[n][k], At[m][k], acc[ai][bj][m][n], 0, 0, 0); __builtin_amdgcn_s_setprio(0); } while (0)
#define PG8_WAIT_V(n) asm volatile("s_waitcnt vmcnt(" #n ")" ::: "memory")
#define PG8_WAIT_L(n) asm volatile("s_waitcnt lgkmcnt(" #n ")" ::: "memory")
#define PG8_BAR __builtin_amdgcn_s_barrier()
#define PG8_SCHED __builtin_amdgcn_sched_barrier(0)
    Unit cur, nxt; int ui = 0;
    if (!S.next(0, cur)) return;
    f32x4 acc[2][2][4][2];
#pragma unroll
    for (int a = 0; a < 2; ++a)
#pragma unroll
        for (int b = 0; b < 2; ++b)
#pragma unroll
            for (int m = 0; m < 4; ++m)
#pragma unroll
                for (int n = 0; n < 2; ++n) acc[a][b][m][n] = (f32x4){0.f, 0.f, 0.f, 0.f};
    bf16x8 At[4][2], B0[2][2], B1[2][2];
    const char* cA = cur.A; const char* cB = cur.B; unsigned lda = cur.lda, ldb = cur.ldb;
    constexpr unsigned kstep = BK * 2;
    PG8_STAGE(PG8_SB(0, 0), cB, RB, ldb); PG8_STAGE(PG8_SB(0, 1), cB + (size_t)HALF * ldb, RB, ldb); PG8_STAGE(PG8_SA(0, 0), cA, RA, lda); PG8_STAGE(PG8_SA(0, 1), cA + (size_t)HALF * lda, RA, lda);
    if (wr == 1) PG8_BAR;
    PG8_WAIT_V(2); PG8_BAR;
    PG8_STAGE(PG8_SB(1, 0), cB + kstep, RB, ldb); PG8_STAGE(PG8_SA(1, 0), cA + kstep, RA, lda); PG8_STAGE(PG8_SB(1, 1), cB + (size_t)HALF * ldb + kstep, RB, ldb);
    PG8_WAIT_V(6); PG8_BAR;
    for (;;) {
        const bool has_next = S.next(ui + 1, nxt);
        const char* nA = has_next ? nxt.A : cA; const char* nB = has_next ? nxt.B : cB; const unsigned nlda = has_next ? nxt.lda : lda, nldb = has_next ? nxt.ldb : ldb;
        const int nt = cur.nt;
        for (int t = 0; t < nt; t += 2) {
            const bool last = (t == nt - 2);
            const char* a1 = cA + (size_t)(t + 1) * kstep;
            const char* a2 = last ? nA : cA + (size_t)(t + 2) * kstep; const char* b2 = last ? nB : cB + (size_t)(t + 2) * kstep;
            const unsigned la2 = last ? nlda : lda, lb2 = last ? nldb : ldb;
            const char* a3 = a2 + kstep; const char* b3 = b2 + kstep;
            PG8_LDB(B0, 0, 0); PG8_LDB(B1, 0, 1); PG8_SCHED; PG8_LDA(At, 0, 0); PG8_STAGE(PG8_SA(1, 1), a1 + (size_t)HALF * lda, RA, lda);
            PG8_WAIT_V(8); PG8_WAIT_L(0); PG8_BAR; PG8_MMA(0, 0, At, B0); PG8_MMA(0, 1, At, B1); PG8_BAR; PG8_SCHED;
            PG8_LDA(At, 0, 1); PG8_STAGE(PG8_SB(0, 0), b2, RB, lb2); PG8_STAGE(PG8_SB(0, 1), b2 + (size_t)HALF * lb2, RB, lb2); PG8_STAGE(PG8_SA(0, 0), a2, RA, la2);
            PG8_WAIT_V(8); PG8_WAIT_L(0); PG8_BAR; PG8_MMA(1, 0, At, B0); PG8_MMA(1, 1, At, B1); PG8_BAR; PG8_SCHED;
            PG8_LDB(B0, 1, 0); PG8_LDB(B1, 1, 1); PG8_SCHED; PG8_LDA(At, 1, 0); PG8_STAGE(PG8_SA(0, 1), a2 + (size_t)HALF * la2, RA, la2);
            PG8_WAIT_V(8); PG8_WAIT_L(0); PG8_BAR; PG8_MMA(0, 0, At, B0); PG8_MMA(0, 1, At, B1); PG8_BAR; PG8_SCHED;
            PG8_LDA(At, 1, 1); PG8_STAGE(PG8_SB(1, 0), b3, RB, lb2); PG8_STAGE(PG8_SB(1, 1), b3 + (size_t)HALF * lb2, RB, lb2); PG8_STAGE(PG8_SA(1, 0), a3, RA, la2);
            PG8_WAIT_V(8); PG8_WAIT_L(0); PG8_BAR; PG8_MMA(1, 0, At, B0); PG8_MMA(1, 1, At, B1); PG8_BAR; PG8_SCHED;
        }
        if (wr == 0) PG8_BAR;
        E(acc, cur, wr, wc, fr, fq);
        if (!has_next) break;
#pragma unroll
        for (int a = 0; a < 2; ++a)
#pragma unroll
            for (int b = 0; b < 2; ++b)
#pragma unroll
                for (int m = 0; m < 4; ++m)
#pragma unroll
                    for (int n = 0; n < 2; ++n) acc[a][b][m][n] = (f32x4){0.f, 0.f, 0.f, 0.f};
        cur = nxt; cA = nA; cB = nB; lda = nlda; ldb = nldb; ++ui;
        if (wr == 1) PG8_BAR;
    }
    PG8_WAIT_V(0);
    PG8_BAR;
#undef PG8_SA
#undef PG8_SB
#undef PG8_STAGE
#undef PG8_LDA
#undef PG8_LDB
#undef PG8_MMA
#undef PG8_WAIT_V
#undef PG8_WAIT_L
#undef PG8_BAR
#undef PG8_SCHED
}
}
using pg8::Unit;

enum { K_QLAT = 0, K_KVLAT, K_U, K_GATES, K_KR, K_QN, K_QR, K_KV, K_SLOC, K_Y, K_GLU, K_AP, K_OUT, K_FFN, K_DOWN };

template <int PH> struct Epi {
    const Ptrs& P; bool dry;
    __device__ __forceinline__ explicit Epi(const Ptrs& p, bool d = false) : P(p), dry(d) {}
    __device__ __forceinline__ void operator()(f32x4 (&acc)[2][2][4][2], const Unit& u, int wr, int wc, int fr, int fq) const {
        const int kind = u.kind;
        if (dry) {
#pragma unroll
            for (int a = 0; a < 2; ++a)
#pragma unroll
                for (int b = 0; b < 2; ++b)
#pragma unroll
                    for (int m = 0; m < 4; ++m)
#pragma unroll
                        for (int n = 0; n < 2; ++n) asm volatile("" :: "v"(acc[a][b][m][n]));
            return; }
#pragma unroll
        for (int ai = 0; ai < 2; ++ai)
#pragma unroll
            for (int m = 0; m < 4; ++m) {
                const int rt = ai * 128 + wr * 64 + m * 16 + fr;
                const int row = u.pm * 256 + rt;
                const int c8 = wc * 32 + fq * 8;
                if constexpr (PH == 1) {
                    const float rs = P.rs1_()[row];
                    if (kind == K_QLAT || kind == K_KVLAT) {
                        bf16* dst = (kind == K_QLAT ? P.qlat_() : P.kvlat_()) + (size_t)row * 512 + (u.pn & 1) * 256 + c8;
                        float ss = 0.f;
#pragma unroll
                        for (int bj = 0; bj < 2; ++bj) { const f32x4 v0 = acc[ai][bj][m][0] * rs, v1 = acc[ai][bj][m][1] * rs;
                            ss += (v0[0] * v0[0] + v0[1] * v0[1]) + (v0[2] * v0[2] + v0[3] * v0[3]) + (v1[0] * v1[0] + v1[1] * v1[1]) + (v1[2] * v1[2] + v1[3] * v1[3]);
                            *(u32x4*)(dst + bj * 128) = pack8(v0, v1); }
                        ss += __shfl_xor(ss, 16); ss += __shfl_xor(ss, 32);
                        if (fq == 0) atomicAdd((kind == K_QLAT ? P.ssq_q_() : P.ssq_kv_()) + row, ss);
                    } else if (kind == K_U) {
#pragma unroll
                        for (int bj = 0; bj < 2; ++bj) { const f32x4 v0 = acc[ai][bj][m][0] * rs, v1 = acc[ai][bj][m][1] * rs;
                            const int chan = (u.pn - 4) * 256 + bj * 128 + c8; const int b = row >> 12, i = row & 4095, c = i >> 4, s = i & 15, g = chan >> 4, p0 = chan & 15;
                            *(u32x4*)(P.ua_() + ((size_t)(g * 512 + b * 256 + c) * KY + s * 16 + p0)) = pack8(v0, v1); }
                    } else {
#pragma unroll
                        for (int bj = 0; bj < 2; ++bj) { f32x4 v0 = acc[ai][bj][m][0] * rs, v1 = acc[ai][bj][m][1] * rs;
#pragma unroll
                            for (int j = 0; j < 4; ++j) { v0[j] = fast_sigmoid(v0[j]); v1[j] = fast_sigmoid(v1[j]); }
                            *(u32x4*)(P.sg_() + (size_t)row * 4096 + (u.pn - 8) * 256 + bj * 128 + c8) = pack8(v0, v1); }
                    }
                } else if constexpr (PH == 2) {
                    if (kind == K_QN) {
                        const float sc = rsqrtf(P.ssq_q_()[row] * (1.0f / 512.0f) + EPS) * QSCALE; const int b = row >> 12, i = row & 4095;
#pragma unroll
                        for (int bj = 0; bj < 2; ++bj) { const int h = u.pn * 2 + bj;
                            *(u32x4*)(P.q_() + ((size_t)(b * NH + h) * SEQ + i) * DQK + c8) = pack8(acc[ai][bj][m][0] * sc, acc[ai][bj][m][1] * sc); }
                    } else if (kind == K_QR) {
                        const float sc = rsqrtf(P.ssq_q_()[row] * (1.0f / 512.0f) + EPS) * QSCALE; const int b = row >> 12, i = row & 4095, pos = NMETA + i;
                        const int jp = (wc & 1) * 4 + fq;
                        const f32x4 cs0 = *(const f32x4*)(P.cs_() + (size_t)pos * 32 + jp * 4), cs1 = *(const f32x4*)(P.cs_() + (size_t)pos * 32 + jp * 4 + 2);
                        const f32x4 cc = {cs0[0], cs0[2], cs1[0], cs1[2]}, sn = {cs0[1], cs0[3], cs1[1], cs1[3]};
#pragma unroll
                        for (int bj = 0; bj < 2; ++bj) { const int h = (u.pn - 8) * 4 + bj * 2 + (wc >> 1);
                            const f32x4 x1 = acc[ai][bj][m][0] * sc, x2 = acc[ai][bj][m][1] * sc; const f32x4 o1 = x1 * cc - x2 * sn, o2 = x2 * cc + x1 * sn;
                            u32x2 w1, w2; w1.x = cvt_pk_bf16(o1[0], o1[1]); w1.y = cvt_pk_bf16(o1[2], o1[3]); w2.x = cvt_pk_bf16(o2[0], o2[1]); w2.y = cvt_pk_bf16(o2[2], o2[3]);
                            bf16* d = P.q_() + ((size_t)(b * NH + h) * SEQ + i) * DQK + DNOPE + jp * 4; *(u32x2*)d = w1; *(u32x2*)(d + 32) = w2; }
                    } else if (kind == K_KV) {
                        const float sc = rsqrtf(P.ssq_kv_()[row] * (1.0f / 512.0f) + EPS); const int h = u.pn, b = row >> 12, pos = NMETA + (row & 4095);
#pragma unroll
                        for (int bj = 0; bj < 2; ++bj) *(u32x4*)((bj == 0 ? P.kn_() : P.v_()) + ((size_t)(b * NH + h) * LPAD + pos) * 128 + c8) = pack8(acc[ai][bj][m][0] * sc, acc[ai][bj][m][1] * sc);
                    } else {
                        float* d = P.sloc_() + ((size_t)(u.aux * 512 + row) * 128 + c8);
                        *(f32x4*)d = acc[ai][0][m][0]; *(f32x4*)(d + 4) = acc[ai][0][m][1];
                    }
                } else if constexpr (PH == 4) {
#pragma unroll
                    for (int bj = 0; bj < 2; ++bj) { f32x4 v0 = acc[ai][bj][m][0], v1 = acc[ai][bj][m][1];
#pragma unroll
                        for (int j = 0; j < 4; ++j) { v0[j] = gelu_tanh(v0[j]); v1[j] = gelu_tanh(v1[j]); }
                        const int t = bj * 8 + wc * 2 + (fq >> 1), p0 = (fq & 1) * 8; const int tok = u.pm * SEQ + rt * TC + t;
                        *(u32x4*)(P.y_() + (size_t)tok * SSMW + u.aux * 16 + p0) = pack8(v0, v1); }
                } else if constexpr (PH == 5) {
                    const int col = u.pn * 128 + c8;
                    f32x4 g0, g1; unpack8(*(const u32x4*)(P.sg_() + (size_t)row * 4096 + 2048 + col), g0, g1);
                    f32x4 v0 = acc[ai][0][m][0], v1 = acc[ai][0][m][1]; const f32x4 t0 = acc[ai][1][m][0], t1 = acc[ai][1][m][1];
#pragma unroll
                    for (int j = 0; j < 4; ++j) { v0[j] = v0[j] * fast_sigmoid(t0[j]) * g0[j]; v1[j] = v1[j] * fast_sigmoid(t1[j]) * g1[j]; }
                    *(u32x4*)(P.pbuf_() + (size_t)row * DM + col) = pack8(v0, v1);
                } else if constexpr (PH == 6) {
#pragma unroll
                    for (int bj = 0; bj < 2; ++bj) { const int col = u.pn * 256 + bj * 128 + c8;
                        f32x4 g0, g1, p0, p1; unpack8(*(const u32x4*)(P.sg_() + (size_t)row * 4096 + col), g0, g1); unpack8(*(const u32x4*)(P.pbuf_() + (size_t)row * DM + col), p0, p1);
                        *(u32x4*)(P.mixed_() + (size_t)row * DM + col) = pack8(acc[ai][bj][m][0] * g0 + p0, acc[ai][bj][m][1] * g1 + p1); }
                } else if constexpr (PH == 7) {
                    float ss = 0.f;
#pragma unroll
                    for (int bj = 0; bj < 2; ++bj) { const int col = u.pn * 256 + bj * 128 + c8; const size_t off = (size_t)row * DM + col;
                        const f32x4 v0 = acc[ai][bj][m][0] + *(const f32x4*)(P.x_() + off), v1 = acc[ai][bj][m][1] + *(const f32x4*)(P.x_() + off + 4);
                        ss += (v0[0] * v0[0] + v0[1] * v0[1]) + (v0[2] * v0[2] + v0[3] * v0[3]) + (v1[0] * v1[0] + v1[1] * v1[1]) + (v1[2] * v1[2] + v1[3] * v1[3]);
                        *(f32x4*)(P.out_() + off) = v0; *(f32x4*)(P.out_() + off + 4) = v1; *(u32x4*)(P.h1b_() + off) = pack8(v0, v1); }
                    ss += __shfl_xor(ss, 16); ss += __shfl_xor(ss, 32);
                    if (fq == 0) atomicAdd(P.ssq_h1_() + row, ss);
                } else if constexpr (PH == 8) {
                    const float rs = rsqrtf(P.ssq_h1_()[row] * (1.0f / 2048.0f) + EPS);
                    f32x4 g0 = acc[ai][0][m][0] * rs, g1 = acc[ai][0][m][1] * rs; const f32x4 u0 = acc[ai][1][m][0] * rs, u1 = acc[ai][1][m][1] * rs;
#pragma unroll
                    for (int j = 0; j < 4; ++j) { g0[j] = g0[j] * fast_sigmoid(g0[j]) * u0[j]; g1[j] = g1[j] * fast_sigmoid(g1[j]) * u1[j]; }
                    *(u32x4*)(P.f_() + (size_t)row * DFF + u.pn * 128 + c8) = pack8(g0, g1);
                } else if constexpr (PH == 9) {
                    float ss = 0.f;
#pragma unroll
                    for (int bj = 0; bj < 2; ++bj) { const size_t off = (size_t)row * DM + u.pn * 256 + bj * 128 + c8;
                        const f32x4 v0 = acc[ai][bj][m][0] + *(const f32x4*)(P.out_() + off), v1 = acc[ai][bj][m][1] + *(const f32x4*)(P.out_() + off + 4);
                        ss += (v0[0] * v0[0] + v0[1] * v0[1]) + (v0[2] * v0[2] + v0[3] * v0[3]) + (v1[0] * v1[0] + v1[1] * v1[1]) + (v1[2] * v1[2] + v1[3] * v1[3]);
                        *(f32x4*)(P.out_() + off) = v0; *(f32x4*)(P.out_() + off + 4) = v1; }
                    ss += __shfl_xor(ss, 16); ss += __shfl_xor(ss, 32);
                    if (fq == 0) atomicAdd(P.ssq_h2_() + row, ss);
                }
            }
    }
};

template <int PH> struct Sched {
    const Ptrs& P; int G, c;
    __device__ __forceinline__ Sched(const Ptrs& p, int g, int c_) : P(p), G(g), c(c_) {}
    __device__ __forceinline__ bool next(int i, Unit& u) const {
        int L = i * G + c; u.aux = 0;
        if constexpr (PH == 1) {
            if (L >= 768) return false; pg8::tile_order(L, 32, 24, u.pm, u.pn);
            u.A = (const char*)P.xb_() + (size_t)u.pm * 256 * 4096; u.B = (const char*)P.win_() + (size_t)u.pn * 256 * 4096; u.lda = 4096; u.ldb = 4096; u.nt = 32;
            u.kind = u.pn < 2 ? K_QLAT : u.pn < 4 ? K_KVLAT : u.pn < 8 ? K_U : K_GATES; return true;
        } else if constexpr (PH == 2) {
            if (L < 128) { const int g = L >> 1; u.pm = L & 1; u.pn = 0; u.aux = g; u.kind = K_SLOC; u.A = (const char*)P.ua_() + (size_t)(g * 512 + u.pm * 256) * (KY * 2); u.B = (const char*)P.bts_() + (size_t)g * 128 * (KS * 2);
                u.lda = KY * 2; u.ldb = KS * 2; u.nt = KS / 64; return true; }
            L -= 128;
            if (L < 512) { pg8::tile_order(L, 32, 16, u.pm, u.pn); u.kind = K_KV; u.A = (const char*)P.kvlat_() + (size_t)u.pm * 256 * 1024; u.B = (const char*)P.wkv_() + (size_t)u.pn * 256 * 1024; u.lda = 1024; u.ldb = 1024; u.nt = 8; return true; }
            L -= 512;
            if (L < 384) { pg8::tile_order(L, 32, 12, u.pm, u.pn); u.kind = u.pn < 8 ? K_QN : K_QR; u.A = (const char*)P.qlat_() + (size_t)u.pm * 256 * 1024; u.B = (const char*)P.wq_() + (size_t)u.pn * 256 * 1024; u.lda = 1024; u.ldb = 1024; u.nt = 8; return true; }
            return false;
        } else if constexpr (PH == 4) {
            if (L >= 128) return false; const int g = L >> 1; u.pm = L & 1; u.pn = 0; u.aux = g; u.kind = K_Y;
            u.A = (const char*)P.ua_() + (size_t)(g * 512 + u.pm * 256) * (KY * 2); u.B = (const char*)P.bty_() + (size_t)g * 256 * (KY * 2); u.lda = KY * 2; u.ldb = KY * 2; u.nt = KY / 64; return true;
        } else if constexpr (PH == 5) {
            if (L >= 32 * 16) return false; pg8::tile_order(L, 32, 16, u.pm, u.pn); u.kind = K_GLU;
            u.A = (const char*)P.y_() + (size_t)u.pm * 256 * 2048; u.B = (const char*)P.wglu_() + (size_t)u.pn * 256 * 2048; u.lda = 2048; u.ldb = 2048; u.nt = 16; return true;
        } else if constexpr (PH == 6 || PH == 7) {
            if (L >= 32 * 8) return false; pg8::tile_order(L, 32, 8, u.pm, u.pn); u.kind = PH == 6 ? K_AP : K_OUT;
            u.A = (const char*)(PH == 6 ? P.o_() : P.mixed_()) + (size_t)u.pm * 256 * 4096; u.B = (const char*)(PH == 6 ? P.wap_() : P.wout_()) + (size_t)u.pn * 256 * 4096; u.lda = 4096; u.ldb = 4096; u.nt = 32; return true;
        } else if constexpr (PH == 8) {
            if (L >= 32 * 44) return false; pg8::tile_order(L, 32, 44, u.pm, u.pn); u.kind = K_FFN;
            u.A = (const char*)P.h1b_() + (size_t)u.pm * 256 * 4096; u.B = (const char*)P.wffn_() + (size_t)u.pn * 256 * 4096; u.lda = 4096; u.ldb = 4096; u.nt = 32; return true;
        } else {
            if (L >= 32 * 8) return false; pg8::tile_order(L, 32, 8, u.pm, u.pn); u.kind = K_DOWN;
            u.A = (const char*)P.f_() + (size_t)u.pm * 256 * (DFF * 2); u.B = (const char*)P.wdown_() + (size_t)u.pn * 256 * (DFF * 2); u.lda = DFF * 2; u.ldb = DFF * 2; u.nt = DFF / 64; return true;
        }
    }
};

namespace att {
constexpr int QBLK = 32, KVBLK = 64, QB = 256;
constexpr int SHM_V = 16384, SHM_K = 16384, SHM_R = 8192;
constexpr int OFF_V = 0, OFF_K = 2 * SHM_V, OFF_R = OFF_K + 2 * SHM_K, OFF_WS = OFF_R + 2 * SHM_R;
constexpr float THRL = 8.f;
#define KSWZ(row, colB) ((row) * 256 + ((colB) ^ (((row) & 7) << 4)))
#define RSWZ(row, chunk) ((row) * 128 + ((((chunk) ^ (row)) & 7) << 4))
__device__ __forceinline__ int v_st(int k, int c) { const int kk = (k & ~0xC) | ((k & 4) << 1) | ((k & 8) >> 1); return ((kk >> 3) * 4 + (c >> 5)) * 512 + ((kk & 7) * 32 + (c & 31)) * 2; }
__device__ __forceinline__ int v_rd_base(int lane) { return ((lane & 3) << 3) | (((lane >> 2) & 3) << 6) | (((lane >> 4) & 1) << 5) | (((lane >> 5) & 1) << 8); }
constexpr int v_rd_off(int d0, int ks, int half) { return d0 * 512 + ks * 4096 + half * 2048; }
__device__ __forceinline__ int crow(int r, int hi) { return (r & 3) + 8 * (r >> 2) + 4 * hi; }

template <int KB>
__device__ __forceinline__ void qkt(f32x16& p0, f32x16& p1, LAS const char* lds, int r32, int hi, const bf16x8* qr) {
    p0 = f32x16{}; p1 = f32x16{};
    LAS const char* kb[4];
#pragma unroll
    for (int dd = 0; dd < 4; ++dd) kb[dd] = lds + OFF_K + KB * SHM_K + KSWZ(r32, (dd * 16 + hi * 8) * 2);
#pragma unroll
    for (int d0 = 0; d0 < 8; ++d0) { LAS const char* a = kb[d0 & 3] + (d0 >> 2) * 128;
        const bf16x8 b0 = *(LAS const bf16x8*)(a); const bf16x8 b1 = *(LAS const bf16x8*)(a + 32 * 256);
        p0 = __builtin_amdgcn_mfma_f32_32x32x16_bf16(b0, qr[d0], p0, 0, 0, 0);
        p1 = __builtin_amdgcn_mfma_f32_32x32x16_bf16(b1, qr[d0], p1, 0, 0, 0); }
#pragma unroll
    for (int d0 = 0; d0 < 4; ++d0) { LAS const char* a = lds + OFF_R + KB * SHM_R + RSWZ(r32, d0 * 2 + hi);
        const bf16x8 b0 = *(LAS const bf16x8*)(a); const bf16x8 b1 = *(LAS const bf16x8*)(a + 32 * 128);
        p0 = __builtin_amdgcn_mfma_f32_32x32x16_bf16(b0, qr[8 + d0], p0, 0, 0, 0);
        p1 = __builtin_amdgcn_mfma_f32_32x32x16_bf16(b1, qr[8 + d0], p1, 0, 0, 0); }
}
template <int VB>
__device__ __forceinline__ void pv_tile(f32x16* o, int vb0, bf16x8 pa0, bf16x8 pa1, bf16x8 pa2, bf16x8 pa3) {
#define TRRD(dst, off) asm volatile("ds_read_b64_tr_b16 %0, %1 offset:%2" : "=&v"(dst) : "v"(vb0), "i"(off) : "memory")
#define PV_D0(d0) do { s16x4 l0, l1, l2, l3, h0, h1, h2, h3; constexpr int b_ = OFF_V + VB * SHM_V + v_rd_off(d0, 0, 0); \
        TRRD(l0, b_); TRRD(h0, b_ + 2048); TRRD(l1, b_ + 4096); TRRD(h1, b_ + 6144); TRRD(l2, b_ + 8192); TRRD(h2, b_ + 10240); TRRD(l3, b_ + 12288); TRRD(h3, b_ + 14336); \
        asm volatile("s_waitcnt lgkmcnt(0)" ::: "memory"); SBAR(); \
        o[d0] = __builtin_amdgcn_mfma_f32_32x32x16_bf16(pa0, (bf16x8){l0[0], l0[1], l0[2], l0[3], h0[0], h0[1], h0[2], h0[3]}, o[d0], 0, 0, 0); \
        o[d0] = __builtin_amdgcn_mfma_f32_32x32x16_bf16(pa1, (bf16x8){l1[0], l1[1], l1[2], l1[3], h1[0], h1[1], h1[2], h1[3]}, o[d0], 0, 0, 0); \
        o[d0] = __builtin_amdgcn_mfma_f32_32x32x16_bf16(pa2, (bf16x8){l2[0], l2[1], l2[2], l2[3], h2[0], h2[1], h2[2], h2[3]}, o[d0], 0, 0, 0); \
        o[d0] = __builtin_amdgcn_mfma_f32_32x32x16_bf16(pa3, (bf16x8){l3[0], l3[1], l3[2], l3[3], h3[0], h3[1], h3[2], h3[3]}, o[d0], 0, 0, 0); } while (0)
    PV_D0(0); PV_D0(1); PV_D0(2); PV_D0(3);
#undef PV_D0
#undef TRRD
}
__device__ __forceinline__ void attn_block(const Ptrs& P, int b, int h, int qb, LAS char* lds) {
    const int tid = threadIdx.x, wid = __builtin_amdgcn_readfirstlane(tid >> 6), lane = tid & 63, r32 = lane & 31, hi = lane >> 5;
    const int i0 = qb * QB, P0 = NMETA + i0;
    const int NT = (P0 + QB - 1) / KVBLK + 1;
    const bf16* Qw = P.q_() + ((size_t)(b * NH + h) * SEQ + i0 + wid * QBLK + r32) * DQK;
    const __amdgpu_buffer_rsrc_t srdK = __builtin_amdgcn_make_buffer_rsrc((void*)(P.kn_() + (size_t)(b * NH + h) * LPAD * 128), (short)0, LPAD * 256, 0x00020000);
    const __amdgpu_buffer_rsrc_t srdV = __builtin_amdgcn_make_buffer_rsrc((void*)(P.v_() + (size_t)(b * NH + h) * LPAD * 128), (short)0, LPAD * 256, 0x00020000);
    const __amdgpu_buffer_rsrc_t srdR = __builtin_amdgcn_make_buffer_rsrc((void*)(P.kr_() + (size_t)b * LPAD * 64), (short)0, LPAD * 128, 0x00020000);
    bf16x8 qr[12];
#pragma unroll
    for (int d0 = 0; d0 < 12; ++d0) qr[d0] = *(const bf16x8*)(Qw + d0 * 16 + hi * 8);
    const int sr = tid >> 4, sc = (tid & 15) * 8, kws = KSWZ(sr, sc * 2), vst0 = v_st(sr, sc), vst1 = v_st(32 + sr, sc);
    const int rr = tid >> 3, rc = tid & 7, rws = RSWZ(rr, rc);
    const int qlo = P0 + wid * QBLK, qm = qlo + r32 - 4 * hi;
    LAS float* wsf = (LAS float*)(lds + OFF_WS) + wid * 64; LAS float* li_l = wsf; LAS float* al_l = wsf + 32;
    const int vb0 = (int)(uintptr_t)(lds) + v_rd_base(lane);
    float m_reg = -1e30f, l_reg = 0.f; f32x16 o[4] = {};
    bf16x8 st_k0, st_k1, st_v0, st_v1, st_r;
    const unsigned gofk = (unsigned)((tid >> 4) * 128 + (tid & 15) * 8) * 2u, gofr = (unsigned)((tid >> 3) * 64 + (tid & 7) * 8) * 2u;
#define BLD(rsrc, vo, so) __builtin_bit_cast(bf16x8, __builtin_amdgcn_raw_buffer_load_b128(rsrc, vo, so, 0))
#define SLOAD(t) do { const int so_ = (t) * (KVBLK * 256); \
        st_k0 = BLD(srdK, gofk, so_); st_k1 = BLD(srdK, gofk, so_ + 8192); st_v0 = BLD(srdV, gofk, so_); st_v1 = BLD(srdV, gofk, so_ + 8192); st_r = BLD(srdR, gofr, (t) * (KVBLK * 128)); } while (0)
#define SWRITE(bf) do { *(LAS bf16x8*)(lds + OFF_K + (bf) * SHM_K + kws) = st_k0; *(LAS bf16x8*)(lds + OFF_K + (bf) * SHM_K + kws + 32 * 256) = st_k1; \
        *(LAS bf16x8*)(lds + OFF_V + (bf) * SHM_V + vst0) = st_v0; *(LAS bf16x8*)(lds + OFF_V + (bf) * SHM_V + vst1) = st_v1; *(LAS bf16x8*)(lds + OFF_R + (bf) * SHM_R + rws) = st_r; } while (0)
    SLOAD(0); SWRITE(0);
    if (NT > 1) SLOAD(1);
    __syncthreads();
    f32x16 p0, p1; bf16x8 pa0, pa1, pa2, pa3;
#define STEP(t, BUF) do { \
        SBAR(); qkt<BUF>(p0, p1, lds, r32, hi, qr); \
        { const int kb_ = (t) * KVBLK; if (kb_ + KVBLK - 1 > qlo) { const int dq = qm - kb_; const float NEG = -__builtin_inff(); \
            _Pragma("unroll") for (int r = 0; r < 16; ++r) { const int c_ = (r & 3) + 8 * (r >> 2); if (dq - c_ < 0) p0[r] = NEG; if (dq - c_ - 32 < 0) p1[r] = NEG; } } } \
        float pmax = p0[0]; _Pragma("unroll") for (int r = 1; r < 16; ++r) pmax = fmaxf(pmax, p0[r]); _Pragma("unroll") for (int r = 0; r < 16; ++r) pmax = fmaxf(pmax, p1[r]); \
        { auto sw_ = __builtin_amdgcn_permlane32_swap(__float_as_uint(pmax), __float_as_uint(pmax), false, false); pmax = fmaxf(__uint_as_float(sw_[0]), __uint_as_float(sw_[1])); } \
        float alpha = 1.f; \
        if (!__all(pmax - m_reg <= THRL)) { const float mn = fmaxf(m_reg, pmax); alpha = __builtin_amdgcn_exp2f(m_reg - mn); m_reg = mn; } \
        _Pragma("unroll") for (int r = 0; r < 16; ++r) { p0[r] = __builtin_amdgcn_exp2f(p0[r] - m_reg); p1[r] = __builtin_amdgcn_exp2f(p1[r] - m_reg); } \
        float ps = 0.f; _Pragma("unroll") for (int r = 0; r < 16; ++r) ps += p0[r]; _Pragma("unroll") for (int r = 0; r < 16; ++r) ps += p1[r]; \
        { auto sw_ = __builtin_amdgcn_permlane32_swap(__float_as_uint(ps), __float_as_uint(ps), false, false); ps = __uint_as_float(sw_[0]) + __uint_as_float(sw_[1]); } \
        l_reg = l_reg * alpha + ps; \
        PK4(p0, 0, pa0); PK4(p0, 8, pa1); PK4(p1, 0, pa2); PK4(p1, 8, pa3); \
        if (__any(alpha < 1.f)) { if (hi == 0) al_l[r32] = alpha; asm volatile("s_waitcnt lgkmcnt(0)" ::: "memory"); \
            _Pragma("unroll") for (int d_ = 0; d_ < 4; ++d_) _Pragma("unroll") for (int r = 0; r < 16; ++r) o[d_][r] *= al_l[crow(r, hi)]; } \
        SBAR(); pv_tile<BUF>(o, vb0, pa0, pa1, pa2, pa3); SBAR(); \
        if ((t) + 1 < NT) SWRITE((BUF) ^ 1); \
        __syncthreads(); \
        if ((t) + 2 < NT) SLOAD((t) + 2); } while (0)
#define PK4(Pv, B_, OUT) do { const unsigned a0 = cvt_pk_bf16(Pv[B_ + 0], Pv[B_ + 1]), a1 = cvt_pk_bf16(Pv[B_ + 2], Pv[B_ + 3]), b0 = cvt_pk_bf16(Pv[B_ + 4], Pv[B_ + 5]), b1 = cvt_pk_bf16(Pv[B_ + 6], Pv[B_ + 7]); \
        auto r0 = __builtin_amdgcn_permlane32_swap(a0, b0, false, false); auto r1 = __builtin_amdgcn_permlane32_swap(a1, b1, false, false); \
        u32x4 w_ = {r0[0], r1[0], r0[1], r1[1]}; OUT = *reinterpret_cast<bf16x8*>(&w_); } while (0)
    int t = 0;
    for (; t + 1 < NT; t += 2) { STEP(t, 0); STEP(t + 1, 1); }
    if (t < NT) STEP(t, 0);
#undef STEP
#undef PK4
#undef SLOAD
#undef BLD
#undef SWRITE
    if (hi == 0) li_l[r32] = l_reg; asm volatile("s_waitcnt lgkmcnt(0)" ::: "memory");
    float rli[16];
#pragma unroll
    for (int r = 0; r < 16; ++r) rli[r] = __builtin_amdgcn_rcpf(li_l[crow(r, hi)]);
    bf16* Ow = P.o_() + ((size_t)(b * SEQ + i0 + wid * QBLK)) * DM + h * DV;
#pragma unroll
    for (int r = 0; r < 16; ++r) { const int orow = crow(r, hi);
#pragma unroll
        for (int d0 = 0; d0 < 4; ++d0) { const float v = o[d0][r] * rli[r]; const float vn = __shfl_xor(v, 1);
            if ((r32 & 1) == 0) *(unsigned*)(Ow + (size_t)orow * DM + d0 * 32 + r32) = cvt_pk_bf16(v, vn); } }
    __syncthreads();
}
#undef KSWZ
#undef RSWZ
}

#define XB_TMO      128
#define XB_XCNT(j)  (256  + 64 * (j))
#define XB_XSUB(j)  (1280 + 64 * (j))
#define XB_XGEN(j)  (2304 + 64 * (j))
#define XB_TOP      3328
#define XB_TOPGEN   3392
#define XCD_BAR_WORDS 3456
#define XB_SPIN_CAP (1u << 18)
__device__ __forceinline__ unsigned xb_ld(unsigned* p)              { return __hip_atomic_load(p, __ATOMIC_RELAXED, __HIP_MEMORY_SCOPE_AGENT); }
__device__ __forceinline__ unsigned xb_add(unsigned* p, unsigned v) { return __hip_atomic_fetch_add(p, v, __ATOMIC_RELAXED, __HIP_MEMORY_SCOPE_AGENT); }
__device__ __forceinline__ unsigned xb_xcc_id() { return (unsigned)__builtin_amdgcn_s_getreg((3 << 11) | 20) & 0xFu; }
#define XB_SPIN(cond, bar) do { unsigned _sp = 0; while (cond) { __builtin_amdgcn_s_sleep(1); \
    if ((++_sp & 255u) == 0u) { if (xb_ld(&(bar)[XB_TMO])) break; if (_sp > XB_SPIN_CAP) { atomicAdd(&(bar)[XB_TMO], 1u); break; } } } } while (0)
struct XcdBarrier { unsigned* bar; unsigned x; volatile LAS unsigned* st; };
__device__ __forceinline__ XcdBarrier xcd_barrier_post(unsigned* bar, volatile LAS unsigned* st) {
    XcdBarrier b; b.bar = bar; b.x = xb_xcc_id(); b.st = st;
    if (threadIdx.x == 0) (void)xb_add(&bar[XB_XCNT(b.x)], 1u);
    return b;
}
__device__ __forceinline__ void xcd_barrier_complete(unsigned* bar, unsigned x, unsigned& nloc, unsigned& nx) {
    const unsigned G = gridDim.x * gridDim.y * gridDim.z;
    unsigned sum, cnt, mine, sp = 0u;
    for (;;) {
        sum = 0u; cnt = 0u; mine = 0u;
#pragma unroll
        for (unsigned j = 0; j < 16; ++j) { const unsigned c = xb_ld(&bar[XB_XCNT(j)]); sum += c; cnt += (c > 0u) ? 1u : 0u; mine = (j == x) ? c : mine; }
        if (sum == G) break;
        __builtin_amdgcn_s_sleep(1);
        if ((++sp & 255u) == 0u) { if (xb_ld(&bar[XB_TMO])) break; if (sp > XB_SPIN_CAP) { atomicAdd(&bar[XB_TMO], 1u); break; } }
    }
    nloc = mine > 0u ? mine : 1u; nx = cnt > 0u ? cnt : 1u;
}
__device__ __forceinline__ void xcd_barrier(const XcdBarrier& b) {
    asm volatile("s_waitcnt vmcnt(0)" ::: "memory");
    __syncthreads();
    if (threadIdx.x == 0) {
        unsigned* bar = b.bar;
        __builtin_amdgcn_s_waitcnt(0);
        unsigned nloc = b.st[0], nx = b.st[1];
        if (nloc == 0u) { xcd_barrier_complete(bar, b.x, nloc, nx); b.st[0] = nloc; b.st[1] = nx; }
        const unsigned old = xb_add(&bar[XB_XSUB(b.x)], 1u);
        const unsigned gen = old / nloc;
        if (old + 1u == (gen + 1u) * nloc) {
            __builtin_amdgcn_fence(__ATOMIC_RELEASE, "agent");
            asm volatile("s_waitcnt vmcnt(0)" ::: "memory");
            const unsigned og = xb_add(&bar[XB_TOP], 1u);
            const unsigned tg = og / nx;
            if (og + 1u == (tg + 1u) * nx) xb_add(&bar[XB_TOPGEN], 1u);
            else XB_SPIN(xb_ld(&bar[XB_TOPGEN]) == tg, bar);
            __builtin_amdgcn_fence(__ATOMIC_ACQUIRE, "agent");
            xb_add(&bar[XB_XGEN(b.x)], 1u);
            asm volatile("s_waitcnt vmcnt(0)" ::: "memory");
        } else {
            XB_SPIN(xb_ld(&bar[XB_XGEN(b.x)]) == gen, bar);
            __builtin_amdgcn_fence(__ATOMIC_ACQUIRE, "agent");
            asm volatile("s_waitcnt vmcnt(0)" ::: "memory");
        }
    }
    __syncthreads();
}

enum { J_WIN = 0, J_WQ, J_WKV, J_WGLU, J_WAP, J_WOUT, J_WFFN, J_WDOWN };
struct ConvSrc { const float* p; };
template <int JOB> __device__ __forceinline__ const float* conv_src(const Ptrs& P, int r) {
    if constexpr (JOB == J_WIN) {
        if (r < 1024) return P.w_in_() + r;
        if (r < 2048) return P.w_in_() + 1088 + (r - 1024);
        if (r < 6144) return P.w_in_() + 2112 + (r - 2048);
        if (r < 6208) { const int rr = r - 6144, jp = rr >> 3, n = (rr >> 2) & 1, j = rr & 3; return P.w_in_() + 1024 + n * 32 + jp * 4 + j; }
        return nullptr;
    } else if constexpr (JOB == J_WQ) {
        if (r < 2048) return P.w_q_up_() + (r >> 7) * 192 + (r & 127);
        const int rr = r - 2048, h = rr >> 6, w = rr & 63, jp = w >> 3, n = (w >> 2) & 1, j = w & 3; return P.w_q_up_() + h * 192 + 128 + n * 32 + jp * 4 + j;
    } else if constexpr (JOB == J_WKV) { return P.w_kv_up_() + r;
    } else if constexpr (JOB == J_WGLU) { const int t = r >> 8, bj = (r >> 7) & 1, c = r & 127; return (bj ? P.w_glu_gate_() : P.w_glu_val_()) + t * 128 + c;
    } else if constexpr (JOB == J_WAP) { return P.w_attn_proj_() + r;
    } else if constexpr (JOB == J_WOUT) { return P.w_out_() + r;
    } else if constexpr (JOB == J_WFFN) { const int t = r >> 8, bj = (r >> 7) & 1, c = r & 127; return (bj ? P.w_ffn_up_() : P.w_ffn_gate_()) + t * 128 + c;
    } else { return P.w_ffn_down_() + r; }
}
template <int JOB> __device__ __forceinline__ void conv_item(const Ptrs& P, int item, int lane) {
    constexpr int K = (JOB == J_WIN || JOB == J_WAP || JOB == J_WOUT || JOB == J_WFFN) ? 2048 : (JOB == J_WQ || JOB == J_WKV) ? 512 : (JOB == J_WGLU) ? 1024 : 5632;
    constexpr int NOUT = (JOB == J_WIN) ? NWIN : (JOB == J_WQ) ? 3072 : (JOB == J_WKV || JOB == J_WGLU) ? 4096 : (JOB == J_WFFN) ? 11264 : 2048;
    constexpr int LDS_ = (JOB == J_WIN) ? INW : (JOB == J_WQ) ? 3072 : (JOB == J_WKV) ? 4096 : (JOB == J_WGLU || JOB == J_WAP || JOB == J_WOUT || JOB == J_WDOWN) ? 2048 : 5632;
    const float* gain = (JOB == J_WIN) ? P.norm_mix_() : (JOB == J_WQ) ? P.norm_q_() : (JOB == J_WKV) ? P.norm_kv_() : (JOB == J_WFFN) ? P.norm_ffn_() : nullptr;
    bf16* WT = (JOB == J_WIN) ? P.win_() : (JOB == J_WQ) ? P.wq_() : (JOB == J_WKV) ? P.wkv_() : (JOB == J_WGLU) ? P.wglu_() : (JOB == J_WAP) ? P.wap_() : (JOB == J_WOUT) ? P.wout_() : (JOB == J_WFFN) ? P.wffn_() : P.wdown_();
    constexpr int nblk = NOUT / 64; const int kb = item / nblk, nb = item % nblk, n0 = 64 * nb + 4 * (lane & 15), kk = 64 * kb + 16 * (lane >> 4);
    const float* src = conv_src<JOB>(P, n0);
    f32x4 v[16];
    if (src) { src += (size_t)kk * LDS_;
#pragma unroll
        for (int i = 0; i < 16; ++i) v[i] = *(const f32x4*)(src + (size_t)i * LDS_);
        if (gain) {
#pragma unroll
            for (int i = 0; i < 4; ++i) { const f32x4 g = *(const f32x4*)(gain + kk + 4 * i); v[4 * i] *= g[0]; v[4 * i + 1] *= g[1]; v[4 * i + 2] *= g[2]; v[4 * i + 3] *= g[3]; } } }
    else {
#pragma unroll
        for (int i = 0; i < 16; ++i) v[i] = (f32x4){0.f, 0.f, 0.f, 0.f}; }
#pragma unroll
    for (int j = 0; j < 4; ++j) { u32x4 o0, o1;
        o0.x = cvt_pk_bf16(v[0][j], v[1][j]); o0.y = cvt_pk_bf16(v[2][j], v[3][j]); o0.z = cvt_pk_bf16(v[4][j], v[5][j]); o0.w = cvt_pk_bf16(v[6][j], v[7][j]);
        o1.x = cvt_pk_bf16(v[8][j], v[9][j]); o1.y = cvt_pk_bf16(v[10][j], v[11][j]); o1.z = cvt_pk_bf16(v[12][j], v[13][j]); o1.w = cvt_pk_bf16(v[14][j], v[15][j]);
        bf16* d = WT + (size_t)(n0 + j) * K + kk; *(u32x4*)d = o0; *(u32x4*)(d + 8) = o1; }
}
constexpr int conv_items(int K, int NOUT) { return (K / 64) * (NOUT / 64); }
__device__ __forceinline__ float wave_sum(float v) {
#pragma unroll
    for (int o = 1; o < 64; o <<= 1) v += __shfl_xor(v, o);
    return v;
}
__device__ __forceinline__ void ssm_build(const Ptrs& P, int g, int part, LAS unsigned char* lds) {
    LAS f32x2* apw = (LAS f32x2*)lds;
    LAS f32x2* bb = (LAS f32x2*)(lds + 17 * 64 * 8);
    LAS f32x2* cc = bb + 64 * 16;
    LAS float* ktab = (LAS float*)(cc + 16 * 64);
    const int tid = threadIdx.x;
    const float step = expf(P.log_step_()[g]);
    if (tid < 64) { const int n = tid; const float lr = P.lam_re_()[g * 64 + n], li = P.lam_im_()[g * 64 + n];
        const float th = li * step, lm = lr * step;
        for (int k = 0; k <= 16; ++k) { const float mag = expf((float)k * lm); float sn, cs; sincosf((float)k * th, &sn, &cs); const f32x2 a = {mag * cs, mag * sn}; apw[k * 64 + n] = a; if (part == 0) P.apow_()[((size_t)g * 17 + k) * 64 + n] = a; }
        const float mag1 = expf(lm); float s1, c1; sincosf(th, &s1, &c1); const float abr = mag1 * c1, abi = mag1 * s1;
        const float den = lr * lr + li * li, nr = abr - 1.0f, ni = abi; const float cr = (nr * lr + ni * li) / den, ci = (ni * lr - nr * li) / den;
        for (int q = 0; q < 16; ++q) { const float br = P.b_re_()[((size_t)g * 64 + n) * 16 + q], bi = P.b_im_()[((size_t)g * 64 + n) * 16 + q];
            const f32x2 w = {cr * br - ci * bi, cr * bi + ci * br}; bb[n * 16 + q] = w; if (part == 0) P.bbar_()[((size_t)g * 64 + n) * 16 + q] = w; } }
    for (int e = tid; e < 1024; e += 512) { const int p = e >> 6, n = e & 63; cc[e] = (f32x2){P.c_re_()[((size_t)g * 16 + p) * 64 + n], P.c_im_()[((size_t)g * 16 + p) * 64 + n]}; }
    __syncthreads();
    for (int e = tid; e < 4096; e += 512) { const int k = e >> 8, p = (e >> 4) & 15, q = e & 15; float acc = 0.f;
        for (int n = 0; n < 64; ++n) { const f32x2 a = apw[k * 64 + n], b = bb[n * 16 + q], c = cc[p * 64 + n];
            const float wr_ = a.x * b.x - a.y * b.y, wi_ = a.x * b.y + a.y * b.x; acc += c.x * wr_ - c.y * wi_; }
        if (k == 0 && p == q) acc += P.ssm_d_()[g * 16 + p];
        ktab[e] = acc; }
    __syncthreads();
    bf16* bty = P.bty_() + (size_t)g * 256 * KY;
    for (int e = tid; e < 64 * KY / 2; e += 512) { const int row = part * 64 + (2 * e) / KY, col = (2 * e) % KY; const int t = row >> 4, p = row & 15; float v[2];
#pragma unroll
        for (int z = 0; z < 2; ++z) { const int cl = col + z;
            if (cl < 256) { const int s = cl >> 4, q = cl & 15; v[z] = (s <= t) ? ktab[((t - s) * 16 + p) * 16 + q] : 0.f; }
            else { const int n = (cl - 256) & 63; const f32x2 a = apw[(t + 1) * 64 + n], c = cc[p * 64 + n]; v[z] = (cl < 320) ? (c.x * a.x - c.y * a.y) : -(c.x * a.y + c.y * a.x); } }
        *(unsigned*)(bty + (size_t)row * KY + col) = cvt_pk_bf16(v[0], v[1]); }
    bf16* bts = P.bts_() + (size_t)g * 128 * KS;
    for (int e = tid; e < 32 * KS / 2; e += 512) { const int row = part * 32 + (2 * e) / KS, col = (2 * e) % KS; const int n = row & 63; float v[2];
#pragma unroll
        for (int z = 0; z < 2; ++z) { const int cl = col + z, s = cl >> 4, q = cl & 15; const f32x2 a = apw[(15 - s) * 64 + n], b = bb[n * 16 + q];
            v[z] = (row < 64) ? (a.x * b.x - a.y * b.y) : (a.x * b.y + a.y * b.x); }
        *(unsigned*)(bts + (size_t)row * KS + col) = cvt_pk_bf16(v[0], v[1]); }
    __syncthreads();
}

enum { MK_KR = 0, MK_KVLAT, MK_UMETA, MK_KVUP };
template <int KIND>
__device__ __forceinline__ void mini_task(const Ptrs& P, const bf16* A, int lda, const bf16* B, int ldb, int K, int row0, int cb, LAS unsigned char* lds) {
    const int tid = threadIdx.x, wave = __builtin_amdgcn_readfirstlane(tid >> 6), lane = tid & 63, r32 = lane & 31, hi = lane >> 5;
    const int kw = K >> 3;
    const bf16* ap = A + (size_t)r32 * lda + wave * kw + hi * 8; const bf16* bp = B + (size_t)r32 * ldb + wave * kw + hi * 8;
    f32x16 c0 = {}, c1 = {};
    for (int k = 0; k < kw; k += 16) { const bf16x8 a = *(const bf16x8*)(ap + k), b0 = *(const bf16x8*)(bp + k), b1 = *(const bf16x8*)(bp + (size_t)32 * ldb + k);
        c0 = __builtin_amdgcn_mfma_f32_32x32x16_bf16(a, b0, c0, 0, 0, 0); c1 = __builtin_amdgcn_mfma_f32_32x32x16_bf16(a, b1, c1, 0, 0, 0); }
    LAS float* red = (LAS float*)lds + wave * 2048;
#pragma unroll
    for (int r = 0; r < 16; ++r) { const int rw = (r & 3) + 8 * (r >> 2) + 4 * hi; red[rw * 64 + r32] = c0[r]; red[rw * 64 + 32 + r32] = c1[r]; }
    __syncthreads();
    const int row = tid >> 4, cg = tid & 15;
    f32x4 v = {0.f, 0.f, 0.f, 0.f};
#pragma unroll
    for (int w = 0; w < 8; ++w) v += *(const LAS f32x4*)((const LAS float*)lds + w * 2048 + row * 64 + cg * 4);
    const int grow = row0 + row;
    const bool meta = row0 >= MTOK;
    if constexpr (KIND == MK_KR) {
        v *= P.rs1_()[grow];
        f32x4 o; { o[0] = __shfl_xor(v[0], 1); o[1] = __shfl_xor(v[1], 1); o[2] = __shfl_xor(v[2], 1); o[3] = __shfl_xor(v[3], 1); }
        const int n = cg & 1, jp = cg >> 1; const f32x4 x1 = n ? o : v, x2 = n ? v : o;
        if (!meta || row < NMETA) { const int pos = meta ? row : NMETA + (grow & 4095);
            const f32x4 cs0 = *(const f32x4*)(P.cs_() + (size_t)pos * 32 + jp * 4), cs1 = *(const f32x4*)(P.cs_() + (size_t)pos * 32 + jp * 4 + 2);
            const f32x4 cc = {cs0[0], cs0[2], cs1[0], cs1[2]}, sn = {cs0[1], cs0[3], cs1[1], cs1[3]};
            const f32x4 ov = n ? (x2 * cc + x1 * sn) : (x1 * cc - x2 * sn);
            u32x2 w; w.x = cvt_pk_bf16(ov[0], ov[1]); w.y = cvt_pk_bf16(ov[2], ov[3]);
            bf16* d = P.kr_() + ((size_t)(meta ? 0 : (grow >> 12)) * LPAD + pos) * 64 + n * 32 + jp * 4; *(u32x2*)d = w;
            if (meta) *(u32x2*)(d + (size_t)LPAD * 64) = w; }
    } else if constexpr (KIND == MK_KVLAT) {
        v *= P.rs1_()[grow];
        u32x2 w; w.x = cvt_pk_bf16(v[0], v[1]); w.y = cvt_pk_bf16(v[2], v[3]);
        *(u32x2*)(P.kvlat_() + (size_t)grow * 512 + cb * 64 + cg * 4) = w;
        float ss = (v[0] * v[0] + v[1] * v[1]) + (v[2] * v[2] + v[3] * v[3]);
        ss += __shfl_xor(ss, 1); ss += __shfl_xor(ss, 2); ss += __shfl_xor(ss, 4); ss += __shfl_xor(ss, 8);
        if (cg == 0) atomicAdd(P.ssq_kv_() + grow, ss);
    } else if constexpr (KIND == MK_UMETA) {
        v *= P.rs1_()[grow];
        if (row < NMETA) *(f32x4*)(P.umeta_() + row * 1024 + cb * 64 + cg * 4) = v;
    } else {
        v *= rsqrtf(P.ssq_kv_()[grow] * (1.0f / 512.0f) + EPS);
        if (row < NMETA) { const int h = cb >> 2, cin = (cb & 3) * 64 + cg * 4;
            u32x2 w; w.x = cvt_pk_bf16(v[0], v[1]); w.y = cvt_pk_bf16(v[2], v[3]);
            bf16* d = (cin < 128 ? P.kn_() : P.v_()) + ((size_t)h * LPAD + row) * 128 + (cin & 127); *(u32x2*)d = w; *(u32x2*)(d + (size_t)NH * LPAD * 128) = w; }
    }
    __syncthreads();
}
__global__ void __launch_bounds__(NWAVES * 64, 2) hybrid_fwd(Args args) {
    extern __shared__ __attribute__((aligned(16))) unsigned char lds_raw[];
    LAS unsigned char* lds = (LAS unsigned char*)lds_raw;
    volatile LAS unsigned* MISC = (volatile LAS unsigned*)(lds + MISC_OFF);
    const int tid = threadIdx.x, lane = tid & 63, wave = __builtin_amdgcn_readfirstlane(tid >> 6);
    const int G = gridDim.x; const int bx = blockIdx.x; const int vcu = (G % 8 == 0) ? (bx % 8) * (G / 8) + bx / 8 : bx;
    const Ptrs P(args);
    for (int u = tid; u < (LDS_BYTES - LDSCTL_OFF) / 4; u += NWAVES * 64) ((LAS unsigned*)(lds + LDSCTL_OFF))[u] = 0u;
    __syncthreads();
    XcdBarrier bar; bar.bar = P.ctl_() + CW_BAR; bar.x = 0; bar.st = nullptr;
    if (!MK_SPLIT) bar = xcd_barrier_post(P.ctl_() + CW_BAR, MISC + 8);
    const int lo = args.ph_lo, hi = args.ph_hi;
#define IN(k) (lo <= (k) && (k) < hi)
#define SEAM(k) do { if (IN(k) && IN((k) + 1)) xcd_barrier(bar); } while (0)
    const int gw = vcu * NWAVES + wave, NGW = G * NWAVES;
    const int gt = vcu * (NWAVES * 64) + tid, NGT = G * NWAVES * 64;

    if (IN(0)) for (int rep0_ = 0; rep0_ < 1 + PROBE_CNT(0); ++rep0_) {
        __syncthreads();
        if (vcu < 4 * NG) ssm_build(P, vcu >> 2, vcu & 3, lds);
        {
            constexpr int I0 = conv_items(2048, NWIN), I1 = conv_items(512, 3072), I2 = conv_items(512, 4096), I3 = conv_items(1024, 4096), I4 = conv_items(2048, 2048);
            for (int it = gw; it < I0 + I1 + I2 + I3 + I4; it += NGW) { int r = it;
                if (r < I0) { conv_item<J_WIN>(P, r, lane); continue; } r -= I0;
                if (r < I1) { conv_item<J_WQ>(P, r, lane); continue; } r -= I1;
                if (r < I2) { conv_item<J_WKV>(P, r, lane); continue; } r -= I2;
                if (r < I3) { conv_item<J_WGLU>(P, r, lane); continue; } r -= I3;
                conv_item<J_WAP>(P, r, lane); }
        }
        for (int m = gw; m < MROWS; m += NGW) {
            GAS u32x2* o8 = (GAS u32x2*)(P.xb_() + (size_t)m * DM) + lane;
            if (m < MTOK + NMETA) { const float* xr = (m < MTOK) ? P.x_() + (size_t)m * DM : P.meta_() + (size_t)(m - MTOK) * DM;
                f32x4 v[8]; float s = 0.f;
#pragma unroll
                for (int j = 0; j < 8; ++j) { v[j] = *((const GAS f32x4*)xr + lane + 64 * j); s += (v[j][0] * v[j][0] + v[j][1] * v[j][1]) + (v[j][2] * v[j][2] + v[j][3] * v[j][3]); }
                s = wave_sum(s); if (lane == 0) P.rs1_()[m] = rsqrtf(s * (1.0f / DM) + EPS);
#pragma unroll
                for (int j = 0; j < 8; ++j) { u32x2 w; w.x = cvt_pk_bf16(v[j][0], v[j][1]); w.y = cvt_pk_bf16(v[j][2], v[j][3]); o8[64 * j] = w; } }
            else { if (lane == 0) P.rs1_()[m] = 1.0f;
#pragma unroll
                for (int j = 0; j < 8; ++j) o8[64 * j] = (u32x2){0u, 0u}; }
        }
        for (int e = gt; e < LTOT * 32; e += NGT) { const int pos = e >> 5, i = e & 31; const float fr_ = (float)pow(10000.0, -(double)i / 32.0); const float ang = (float)pos * fr_;
            P.cs_()[e] = (f32x2){(float)cos((double)ang), (float)sin((double)ang)}; }
        for (int e = gt; e < NBATCH * NH * (LPAD - LTOT) * 16; e += NGT) { const int bh = e / ((LPAD - LTOT) * 16), r = e % ((LPAD - LTOT) * 16); const size_t off = ((size_t)bh * LPAD + LTOT) * 128 + (size_t)r * 8;
            *(u32x4*)(P.kn_() + off) = (u32x4){0u, 0u, 0u, 0u}; *(u32x4*)(P.v_() + off) = (u32x4){0u, 0u, 0u, 0u}; }
        for (int e = gt; e < NBATCH * (LPAD - LTOT) * 8; e += NGT) { const int b = e / ((LPAD - LTOT) * 8), r = e % ((LPAD - LTOT) * 8); *(u32x4*)(P.kr_() + ((size_t)b * LPAD + LTOT) * 64 + (size_t)r * 8) = (u32x4){0u, 0u, 0u, 0u}; }
        for (int e = gt; e < 128 * KS / 8; e += NGT) *(u32x4*)(P.bts_() + (size_t)NG * 128 * KS + (size_t)e * 8) = (u32x4){0u, 0u, 0u, 0u};
    }
    SEAM(0);
    if (IN(1)) {
        Sched<1> S(P, G, bx); Epi<1> E(P); pg8::gemm_run(lds, S, E);
        __syncthreads();
        for (int tk = vcu; tk < 257 + 24; tk += G) {
            if (tk < 257) mini_task<MK_KR>(P, P.xb_() + (size_t)tk * 32 * DM, DM, P.win_() + (size_t)6144 * DM, DM, DM, tk * 32, 0, lds);
            else { const int cbm = tk - 257;
                if (cbm < 8) mini_task<MK_KVLAT>(P, P.xb_() + (size_t)MTOK * DM, DM, P.win_() + (size_t)(512 + 64 * cbm) * DM, DM, DM, MTOK, cbm, lds);
                else mini_task<MK_UMETA>(P, P.xb_() + (size_t)MTOK * DM, DM, P.win_() + (size_t)(1024 + 64 * (cbm - 8)) * DM, DM, DM, MTOK, cbm - 8, lds); } }
        for (int rep_ = 0; rep_ < PROBE_CNT(1); ++rep_) { __syncthreads(); Epi<1> E2(P, true); pg8::gemm_run(lds, S, E2); } }
    SEAM(1);
    if (IN(2)) for (int rep2_ = 0; rep2_ < 1 + PROBE_CNT(2); ++rep2_) {
        __syncthreads();
        for (int tk = vcu; tk < 64; tk += G) mini_task<MK_KVUP>(P, P.kvlat_() + (size_t)MTOK * 512, 512, P.wkv_() + (size_t)tk * 64 * 512, 512, 512, MTOK, tk, lds);
        if (vcu >= 64 && vcu < 72) { const int e = (vcu - 64) * 512 + tid, g = e >> 6, n = e & 63; float xr = 0.f, xi = 0.f;
            for (int s = 0; s < NMETA; ++s) { const f32x2 a = P.apow_()[((size_t)g * 17 + (15 - s)) * 64 + n]; float br = 0.f, bi = 0.f;
                for (int q = 0; q < 16; ++q) { const f32x2 w = P.bbar_()[((size_t)g * 64 + n) * 16 + q]; const float uu = P.umeta_()[s * 1024 + g * 16 + q]; br += w.x * uu; bi += w.y * uu; }
                xr += a.x * br - a.y * bi; xi += a.x * bi + a.y * br; }
            P.x0_()[e] = (f32x2){xr, xi}; }
        Sched<2> S(P, G, bx); Epi<2> E(P); pg8::gemm_run(lds, S, E);
    }
    SEAM(2);
    if (IN(3)) {
        {
            const int w = vcu; const int b = w >> 7, g = (w >> 1) & 63, n = (w & 1) * 32 + (tid & 31), seg = tid >> 5;
            if (w < 256) {
                const f32x2 A16 = P.apow_()[((size_t)g * 17 + 16) * 64 + n];
                f32x2 A256 = A16;
#pragma unroll
                for (int z = 0; z < 4; ++z) A256 = (f32x2){A256.x * A256.x - A256.y * A256.y, 2.f * A256.x * A256.y};
                const float* sl = P.sloc_() + ((size_t)(g * 512 + b * 256 + seg * 16)) * 128 + n;
                float sre[16], sim[16];
#pragma unroll
                for (int j = 0; j < 16; ++j) { sre[j] = sl[j * 128]; sim[j] = sl[j * 128 + 64]; }
                float tr = 0.f, ti = 0.f;
#pragma unroll
                for (int j = 0; j < 16; ++j) { const float nr = A16.x * tr - A16.y * ti + sre[j], ni = A16.x * ti + A16.y * tr + sim[j]; tr = nr; ti = ni; }
                LAS f32x2* T = (LAS f32x2*)lds;
                T[seg * 32 + (tid & 31)] = (f32x2){tr, ti};
                __syncthreads();
                const f32x2 x0v = P.x0_()[g * 64 + n]; float xr = x0v.x, xi = x0v.y;
                for (int s2 = 0; s2 < seg; ++s2) { const f32x2 tv = T[s2 * 32 + (tid & 31)]; const float nr = A256.x * xr - A256.y * xi + tv.x, ni = A256.x * xi + A256.y * xr + tv.y; xr = nr; xi = ni; }
                bf16* ua = P.ua_() + ((size_t)(g * 512 + b * 256 + seg * 16)) * KY + 256 + n;
#pragma unroll
                for (int j = 0; j < 16; ++j) { ua[(size_t)j * KY] = (bf16)(cvt_pk_bf16(xr, 0.f) & 0xffffu); ua[(size_t)j * KY + 64] = (bf16)(cvt_pk_bf16(xi, 0.f) & 0xffffu);
                    const float nr = A16.x * xr - A16.y * xi + sre[j], ni = A16.x * xi + A16.y * xr + sim[j]; xr = nr; xi = ni; }
            }
            __syncthreads();
        }
        for (int rep_ = 0; rep_ < PROBE_ATT; ++rep_)
        for (int it = vcu; it < 256; it += G) { const int bh = it >> 3, xq = it & 7;
            for (int pass = 0; pass < 2; ++pass) att::attn_block(P, bh >> 4, bh & 15, pass ? 15 - xq : xq, (LAS char*)lds); }
    }
    SEAM(3);
    if (IN(4)) for (int rep4_ = 0; rep4_ < 1 + PROBE_CNT(4); ++rep4_) {
        __syncthreads();
        constexpr int I0 = conv_items(2048, 2048), I1 = conv_items(2048, 11264), I2 = conv_items(5632, 2048);
        {
            const bool heavy = bx < 128; const int nsl = heavy ? 2 : 3; const int s0 = heavy ? (bx * NWAVES + wave) * 2 : 128 * NWAVES * 2 + ((bx - 128) * NWAVES + wave) * 3;
            const int NSL = 128 * NWAVES * 2 + (G - 128) * NWAVES * 3;
            for (int base = 0; base < I0 + I1 + I2; base += NSL)
                for (int k = 0; k < nsl; ++k) { int r = base + s0 + k; if (r >= I0 + I1 + I2) break;
                    if (r < I0) { conv_item<J_WOUT>(P, r, lane); continue; } r -= I0;
                    if (r < I1) { conv_item<J_WFFN>(P, r, lane); continue; } r -= I1;
                    conv_item<J_WDOWN>(P, r, lane); }
        }
        __syncthreads();
        Sched<4> S(P, G, bx); Epi<4> E(P); pg8::gemm_run(lds, S, E);
    }
    SEAM(4);
    if (IN(5)) { Sched<5> S(P, G, bx); Epi<5> E(P); pg8::gemm_run(lds, S, E);
        for (int rep_ = 0; rep_ < PROBE_CNT(5); ++rep_) { __syncthreads(); Epi<5> E2(P, false); pg8::gemm_run(lds, S, E2); } }
    SEAM(5);
    if (IN(6)) { Sched<6> S(P, G, bx); Epi<6> E(P); pg8::gemm_run(lds, S, E);
        for (int rep_ = 0; rep_ < PROBE_CNT(6); ++rep_) { __syncthreads(); Epi<6> E2(P, false); pg8::gemm_run(lds, S, E2); } }
    SEAM(6);
    if (IN(7)) { Sched<7> S(P, G, bx); Epi<7> E(P); pg8::gemm_run(lds, S, E);
        for (int rep_ = 0; rep_ < PROBE_CNT(7); ++rep_) { __syncthreads(); Epi<7> E2(P, true); pg8::gemm_run(lds, S, E2); } }
    SEAM(7);
    if (IN(8)) { Sched<8> S(P, G, bx); Epi<8> E(P); pg8::gemm_run(lds, S, E);
        for (int rep_ = 0; rep_ < PROBE_CNT(8); ++rep_) { __syncthreads(); Epi<8> E2(P, false); pg8::gemm_run(lds, S, E2); } }
    SEAM(8);
    if (IN(9)) { Sched<9> S(P, G, bx); Epi<9> E(P); pg8::gemm_run(lds, S, E);
        for (int rep_ = 0; rep_ < PROBE_CNT(9); ++rep_) { __syncthreads(); Epi<9> E2(P, true); pg8::gemm_run(lds, S, E2); } }
    SEAM(9);
    if (IN(10)) {
        const bool bad = __hip_atomic_load(P.ctl_() + CW_BAR + XB_TMO, RLX_AGENT) != 0u;
        unsigned lane_ = threadIdx.x; asm volatile("" : "+v"(lane_)); lane_ &= 63u;
        for (int m = gw; m < MTOK; m += NGW) { const float rs = bad ? __builtin_nanf("") : rsqrtf(P.ssq_h2_()[m] * (1.0f / DM) + EPS);
            GAS f32x4* o = (GAS f32x4*)(P.out_() + (size_t)m * DM) + lane_;
#pragma unroll
            for (int j = 0; j < 8; ++j) { const f32x4 g = *((const GAS f32x4*)P.norm_final_() + lane_ + 64 * j); o[64 * j] = o[64 * j] * rs * g; } }
    }
#undef IN
#undef SEAM
}

extern "C" void kernel_launch(void* const* d_in, const int* in_sizes, int n_in, void* d_out, int out_size, void* d_ws, size_t ws_size, hipStream_t stream) {
    static int grid = 0;
    if (grid == 0) {
        if (n_in != 25 || in_sizes[0] != MTOK * DM || out_size != MTOK * DM || ws_size < WS_END) {
            fprintf(stderr, "kernel_launch: unexpected shapes (n_in %d, in0 %d, out %d, ws %zu < %zu)\n", n_in, n_in > 0 ? in_sizes[0] : -1, out_size, ws_size, (size_t)WS_END); grid = -1; return; }
        int dev = 0, cus = 0, per_cu = 0;
        if (hipGetDevice(&dev) != hipSuccess || hipDeviceGetAttribute(&cus, hipDeviceAttributeMultiprocessorCount, dev) != hipSuccess) { grid = -1; return; }
        if (hipFuncSetAttribute((const void*)hybrid_fwd, hipFuncAttributeMaxDynamicSharedMemorySize, LDS_BYTES) != hipSuccess) { fprintf(stderr, "kernel_launch: hipFuncSetAttribute failed\n"); grid = -1; return; }
        if (hipOccupancyMaxActiveBlocksPerMultiprocessor(&per_cu, (const void*)hybrid_fwd, NWAVES * 64, LDS_BYTES) != hipSuccess || per_cu < 1) {
            fprintf(stderr, "kernel_launch: occupancy query reports %d workgroups per CU\n", per_cu); (void)hipGetLastError(); grid = -1; return; }
        grid = cus;
    }
    if (grid < 0) return;
    if (hipMemsetAsync((char*)d_ws + WS_CTL, 0, CTL_ZERO_BYTES, stream) != hipSuccess) { fprintf(stderr, "kernel_launch: memset failed\n"); return; }
    Args a{};
    for (int i = 0; i < 25; ++i) a.in[i] = (const float*)d_in[i];
    a.out = (float*)d_out; a.ws = (unsigned char*)d_ws;
#if MK_SPLIT
    for (int ph = 0; ph < N_PHASES; ++ph) { a.ph_lo = ph; a.ph_hi = ph + 1; hipLaunchKernelGGL(hybrid_fwd, dim3(grid), dim3(NWAVES * 64), LDS_BYTES, stream, a); }
#else
    a.ph_lo = 0; a.ph_hi = N_PHASES;
    hipLaunchKernelGGL(hybrid_fwd, dim3(grid), dim3(NWAVES * 64), LDS_BYTES, stream, a);
#endif
    const hipError_t le = hipPeekAtLastError();
    if (le != hipSuccess) fprintf(stderr, "kernel_launch: launch failed: %s\n", hipGetErrorName(le));
}
```
